# Optimizing an MI355X kernel written in HIP

```python
import jax
import jax.numpy as jnp
from jax import lax
import numpy as np

D_MODEL = 1024
BATCH = 2
SEQ = 8192
DEPTH = 2

MIX = D_MODEL // 2
MOBA_HEAD_DIM = 64
MOBA_HEADS = MIX // MOBA_HEAD_DIM
MOBA_BLOCK = 256
MOBA_TOPK = 3
Q_BLOCK = 128
ROPE_THETA = 500000.0
ROPE_DIMS = MOBA_HEAD_DIM // 4
GLA_HEADS = 4
GLA_DK = MIX // 2
GLA_DV = MIX
GLA_GATE_RANK = 16
GLA_TAU = 16.0
GLA_CHUNK = 64
MLSTM_HEADS = 4
MLSTM_DQK = MIX
MLSTM_DV = MIX
MLSTM_CONV = 4
MLSTM_CHUNK = 64
N_BRANCHES = 3
D_FF = ((8 * D_MODEL // 3 + 255) // 256) * 256
N_EXPERTS = 8
TOP_K = 2
MOE_BLOCK = 256
EPS = 1e-6

IN_LAYOUT = (
    ('moba_q', MIX), ('moba_k', MIX), ('moba_v', MIX),
    ('gla_q', GLA_DK), ('gla_k', GLA_DK), ('gla_v', GLA_DV),
    ('gla_a', GLA_GATE_RANK), ('gla_r', GLA_DV),
    ('mlstm_q', MLSTM_DQK), ('mlstm_k', MLSTM_DQK), ('mlstm_v', MLSTM_DV),
    ('mlstm_i', MLSTM_HEADS), ('mlstm_f', MLSTM_HEADS), ('mlstm_o', MLSTM_DV),
    ('merge_gate', N_BRANCHES * D_MODEL),
)
N_IN = sum(size for _, size in IN_LAYOUT)

kernel_name = 'hybrid_moba_gla_mlstm_moe_block'


def _col_offset(name):
    off = 0
    for n, size in IN_LAYOUT:
        if n == name:
            return off
        off += size
    raise KeyError(name)


def _split_in(z):
    out = {}
    off = 0
    for n, size in IN_LAYOUT:
        out[n] = z[..., off:off + size]
        off += size
    return out


def rmsnorm(x, g):
    xf = x.astype(jnp.float32)
    y = xf * lax.rsqrt(jnp.mean(xf * xf, axis=-1, keepdims=True) + EPS)
    return (y * g.astype(jnp.float32)).astype(x.dtype)


def to_heads(t, nh):
    b, s, _ = t.shape
    return t.reshape(b, s, nh, -1).transpose(0, 2, 1, 3)


def from_heads(t):
    b, nh, s, hd = t.shape
    return t.transpose(0, 2, 1, 3).reshape(b, s, nh * hd)


def partial_rope(x, pos):
    half = ROPE_DIMS // 2
    inv_freq = jnp.power(ROPE_THETA, -jnp.arange(half, dtype=jnp.float32) * 2.0 / ROPE_DIMS)
    ang = pos.astype(jnp.float32)[:, None] * inv_freq[None, :]
    cos, sin = jnp.cos(ang), jnp.sin(ang)
    xr = x[..., :ROPE_DIMS].astype(jnp.float32)
    x1, x2 = xr[..., :half], xr[..., half:]
    rot = jnp.concatenate([x1 * cos - x2 * sin, x2 * cos + x1 * sin], axis=-1)
    return jnp.concatenate([rot.astype(x.dtype), x[..., ROPE_DIMS:]], axis=-1)


def moba_attention(q, k, v):
    f32 = jnp.float32
    b, nh, s, hd = q.shape
    nb = -(-s // MOBA_BLOCK)
    n_sel = min(MOBA_TOPK, nb)
    pad = nb * MOBA_BLOCK - s
    kb = jnp.pad(k, ((0, 0), (0, 0), (0, pad), (0, 0))).reshape(b, nh, nb, MOBA_BLOCK, hd)
    vb = jnp.pad(v, ((0, 0), (0, 0), (0, pad), (0, 0))).reshape(b, nh, nb, MOBA_BLOCK, hd)
    k_mean = jnp.mean(kb.astype(f32), axis=3)
    nq = s // Q_BLOCK
    q_blocks = q.reshape(b, nh, nq, Q_BLOCK, hd).transpose(2, 0, 1, 3, 4)
    bi = jnp.arange(b)[:, None, None, None]
    hi = jnp.arange(nh)[None, :, None, None]
    blk_ids = jnp.arange(nb)
    scale = hd ** -0.5
    n_cols = n_sel * MOBA_BLOCK

    def one_block(args):
        qb, c = args
        q_pos = c * Q_BLOCK + jnp.arange(Q_BLOCK)
        cur = (c * Q_BLOCK) // MOBA_BLOCK
        gate = jnp.einsum('bhqd,bhnd->bhqn', qb.astype(f32), k_mean)
        gate = jnp.where(blk_ids < cur, gate, -jnp.inf)
        _, sel = lax.top_k(gate, n_sel)
        sel_ok = jnp.arange(n_sel) < cur
        k_sel = kb[bi, hi, sel]
        v_sel = vb[bi, hi, sel]
        s_sel = jnp.einsum('bhqd,bhqrtd->bhqrt', qb, k_sel).astype(f32) * scale
        s_sel = jnp.where(sel_ok[:, None], s_sel, -jnp.inf)
        k_own = lax.dynamic_index_in_dim(kb, cur, axis=2, keepdims=False)
        v_own = lax.dynamic_index_in_dim(vb, cur, axis=2, keepdims=False)
        s_own = jnp.einsum('bhqd,bhtd->bhqt', qb, k_own).astype(f32) * scale
        own_pos = cur * MOBA_BLOCK + jnp.arange(MOBA_BLOCK)
        s_own = jnp.where(own_pos[None, :] <= q_pos[:, None], s_own, -jnp.inf)
        p = jax.nn.softmax(jnp.concatenate([s_sel.reshape(b, nh, Q_BLOCK, n_cols), s_own], axis=-1), axis=-1)
        p_sel = p[..., :n_cols].reshape(b, nh, Q_BLOCK, n_sel, MOBA_BLOCK).astype(v.dtype)
        p_own = p[..., n_cols:].astype(v.dtype)
        return (jnp.einsum('bhqrt,bhqrtd->bhqd', p_sel, v_sel)
                + jnp.einsum('bhqt,bhtd->bhqd', p_own, v_own))

    out = lax.map(one_block, (q_blocks, jnp.arange(nq)))
    return out.transpose(1, 2, 0, 3, 4).reshape(b, nh, s, hd)


def gla_chunked(q, k, v, log_a):
    b, nh, s, dk = q.shape
    dv = v.shape[-1]
    L = GLA_CHUNK
    nc = s // L
    q = q * dk ** -0.5
    qc = q.reshape(b, nh, nc, L, dk)
    kc = k.reshape(b, nh, nc, L, dk)
    vc = v.reshape(b, nh, nc, L, dv)
    cum = jnp.cumsum(log_a.reshape(b, nh, nc, L, dk), axis=3)
    cum_last = cum[:, :, :, -1:, :]
    q_dec = qc * jnp.exp(cum)
    k_inv = kc * jnp.exp(-cum)
    k_to_end = kc * jnp.exp(cum_last - cum)
    causal = jnp.tril(jnp.ones((L, L), dtype=bool))
    att = jnp.where(causal, jnp.einsum('bhcid,bhcjd->bhcij', q_dec, k_inv), 0.0)
    o_intra = jnp.einsum('bhcij,bhcje->bhcie', att, vc)

    def step(state, inp):
        dec, kk, vv = inp
        new = dec[..., None] * state + jnp.einsum('bhjd,bhje->bhde', kk, vv)
        return new, state

    xs = (jnp.exp(cum_last[:, :, :, 0, :]).transpose(2, 0, 1, 3),
          k_to_end.transpose(2, 0, 1, 3, 4), vc.transpose(2, 0, 1, 3, 4))
    _, s_prev = lax.scan(step, jnp.zeros((b, nh, dk, dv), jnp.float32), xs)
    o_inter = jnp.einsum('bhcid,cbhde->bhcie', q_dec, s_prev)
    return (o_intra + o_inter).reshape(b, nh, s, dv)


def mlstm_chunked(q, k, v, i_pre, f_pre):
    b, nh, s, dk = q.shape
    dv = v.shape[-1]
    L = MLSTM_CHUNK
    nc = s // L
    k = k * dk ** -0.5
    qc = q.reshape(b, nh, nc, L, dk)
    kc = k.reshape(b, nh, nc, L, dk)
    vc = v.reshape(b, nh, nc, L, dv)
    ic = i_pre.reshape(b, nh, nc, L)
    cum = jnp.cumsum(jax.nn.log_sigmoid(f_pre).reshape(b, nh, nc, L), axis=-1)
    cum_last = cum[..., -1]
    a_end = cum_last[..., None] - cum + ic

    def step(carry, inp):
        c_st, n_st, m_st = carry
        bl, aa, kk, vv = inp
        m_new = jnp.maximum(bl + m_st, jnp.max(aa, axis=-1))
        w = jnp.exp(aa - m_new[..., None])
        dec = jnp.exp(bl + m_st - m_new)
        c_new = dec[..., None, None] * c_st + jnp.einsum('bhj,bhjd,bhje->bhde', w, kk, vv)
        n_new = dec[..., None] * n_st + jnp.einsum('bhj,bhjd->bhd', w, kk)
        return (c_new, n_new, m_new), (c_st, n_st, m_st)

    init = (jnp.zeros((b, nh, dk, dv), jnp.float32), jnp.zeros((b, nh, dk), jnp.float32),
            jnp.zeros((b, nh), jnp.float32))
    xs = (cum_last.transpose(2, 0, 1), a_end.transpose(2, 0, 1, 3),
          kc.transpose(2, 0, 1, 3, 4), vc.transpose(2, 0, 1, 3, 4))
    _, (c_prev, n_prev, m_prev) = lax.scan(step, init, xs)
    c_prev = c_prev.transpose(1, 2, 0, 3, 4)
    n_prev = n_prev.transpose(1, 2, 0, 3)
    m_prev = m_prev.transpose(1, 2, 0)
    causal = jnp.tril(jnp.ones((L, L), dtype=bool))
    log_d = jnp.where(causal, cum[..., :, None] - cum[..., None, :] + ic[..., None, :], -jnp.inf)
    log_inter = cum + m_prev[..., None]
    m_i = jnp.maximum(log_inter, jnp.max(log_d, axis=-1))
    w_intra = jnp.einsum('bhcid,bhcjd->bhcij', qc, kc) * jnp.exp(log_d - m_i[..., None])
    w_inter = jnp.exp(log_inter - m_i)
    num = (w_inter[..., None] * jnp.einsum('bhcid,bhcde->bhcie', qc, c_prev)
           + jnp.einsum('bhcij,bhcje->bhcie', w_intra, vc))
    den = w_inter * jnp.einsum('bhcid,bhcd->bhci', qc, n_prev) + jnp.sum(w_intra, axis=-1)
    h = num / jnp.maximum(jnp.abs(den), jnp.exp(-m_i))[..., None]
    return h.reshape(b, nh, s, dv)


def causal_depthwise_conv(x, w, bias):
    y = lax.conv_general_dilated(x, w[:, None, :], window_strides=(1,),
                                 padding=[(w.shape[0] - 1, 0)],
                                 dimension_numbers=('NWC', 'WIO', 'NWC'),
                                 feature_group_count=x.shape[-1])
    return y + bias


def hybrid_mixer(h, w_in, b_in, mlstm_conv_w, mlstm_conv_b, gla_gate_w, gla_gate_b,
                 gla_norm_g, w_up_moba, w_up_gla, w_up_mlstm, w_o):
    f32 = jnp.float32
    dt = h.dtype
    b, s, _ = h.shape
    z = _split_in(h @ w_in + b_in)
    pos = jnp.arange(s)

    q = partial_rope(to_heads(z['moba_q'], MOBA_HEADS), pos)
    k = partial_rope(to_heads(z['moba_k'], MOBA_HEADS), pos)
    y_moba = from_heads(moba_attention(q, k, to_heads(z['moba_v'], MOBA_HEADS)))

    log_a = jax.nn.log_sigmoid((z['gla_a'] @ gla_gate_w + gla_gate_b).astype(f32)) / GLA_TAU
    o = gla_chunked(to_heads(z['gla_q'], GLA_HEADS).astype(f32), to_heads(z['gla_k'], GLA_HEADS).astype(f32),
                    to_heads(z['gla_v'], GLA_HEADS).astype(f32), to_heads(log_a, GLA_HEADS))
    o = o * lax.rsqrt(jnp.mean(o * o, axis=-1, keepdims=True) + EPS)
    y_gla = (from_heads(o) * gla_norm_g.astype(f32) * jax.nn.silu(z['gla_r'].astype(f32))).astype(dt)

    qk = jax.nn.silu(causal_depthwise_conv(jnp.concatenate([z['mlstm_q'], z['mlstm_k']], axis=-1),
                                           mlstm_conv_w, mlstm_conv_b))
    mq, mk = qk[..., :MLSTM_DQK], qk[..., MLSTM_DQK:]
    hm = mlstm_chunked(to_heads(mq, MLSTM_HEADS).astype(f32), to_heads(mk, MLSTM_HEADS).astype(f32),
                       to_heads(z['mlstm_v'], MLSTM_HEADS).astype(f32),
                       z['mlstm_i'].astype(f32).transpose(0, 2, 1), z['mlstm_f'].astype(f32).transpose(0, 2, 1))
    y_mlstm = (from_heads(hm) * jax.nn.sigmoid(z['mlstm_o'].astype(f32))).astype(dt)

    g = jax.nn.sigmoid(z['merge_gate'].astype(f32)).astype(dt).reshape(b, s, N_BRANCHES, D_MODEL)
    merged = (g[:, :, 0] * (y_moba @ w_up_moba) + g[:, :, 1] * (y_gla @ w_up_gla)
              + g[:, :, 2] * (y_mlstm @ w_up_mlstm))
    return merged @ w_o


def swiglu(x, w_gate, w_up, w_down):
    return (jax.nn.silu(x @ w_gate) * (x @ w_up)) @ w_down


def moe_swiglu(x, router_w, router_b, w_gate, w_up, w_down):
    b, s, d = x.shape
    t = b * s
    xt = x.reshape(t, d)
    logits = (xt @ router_w).astype(jnp.float32) + router_b.astype(jnp.float32)
    top_logit, top_e = lax.top_k(logits, TOP_K)
    gate = jax.nn.softmax(top_logit, axis=-1)
    n_pairs = t * TOP_K
    e_flat = top_e.reshape(n_pairs)
    tok_flat = jnp.repeat(jnp.arange(t, dtype=jnp.int32), TOP_K)
    g_flat = gate.reshape(n_pairs)
    order = jnp.argsort(e_flat)
    e_s, tok_s, g_s = e_flat[order], tok_flat[order], g_flat[order]
    counts = jnp.bincount(e_flat, length=N_EXPERTS)
    starts = jnp.cumsum(counts) - counts
    padded = (counts + MOE_BLOCK - 1) // MOE_BLOCK * MOE_BLOCK
    pad_ends = jnp.cumsum(padded)
    pad_starts = pad_ends - padded
    dest = pad_starts[e_s] + jnp.arange(n_pairs) - starts[e_s]
    n_rows = ((n_pairs + MOE_BLOCK - 1) // MOE_BLOCK + N_EXPERTS) * MOE_BLOCK
    n_blk = n_rows // MOE_BLOCK
    rows_tok = jnp.full((n_rows,), t, jnp.int32).at[dest].set(tok_s)
    rows_g = jnp.zeros((n_rows,), x.dtype).at[dest].set(g_s.astype(x.dtype))
    blk_e = jnp.minimum(jnp.searchsorted(pad_ends, jnp.arange(n_blk) * MOE_BLOCK, side='right'),
                        N_EXPERTS - 1)
    x_pad = jnp.concatenate([xt, jnp.zeros((1, d), xt.dtype)], axis=0)

    def block(args):
        tok, e = args
        xb = x_pad[tok]
        return swiglu(xb, w_gate[e], w_up[e], w_down[e])

    y_rows = lax.map(block, (rows_tok.reshape(n_blk, MOE_BLOCK), blk_e)).reshape(n_rows, d)
    y_rows = y_rows * rows_g[:, None]
    out = jnp.zeros((t + 1, d), x.dtype).at[rows_tok].add(y_rows)[:t]
    return out.reshape(b, s, d)


def setup_inputs(seed: int = 0) -> dict:
    key = jax.random.key(seed)
    ks = jax.random.split(key, 26)
    f32 = jnp.float32

    def nrm(k, shape, scale):
        return jax.random.normal(k, shape, f32) * scale

    n_dense = (DEPTH + 1) // 2
    n_moe = DEPTH // 2
    f_off = _col_offset('mlstm_f')
    b_in = nrm(ks[3], (DEPTH, N_IN), 0.02)
    b_in = b_in.at[:, f_off:f_off + MLSTM_HEADS].add(jnp.linspace(3.0, 6.0, MLSTM_HEADS))
    return {
        'x': nrm(ks[0], (BATCH, SEQ, D_MODEL), 1.0),
        'attn_norm_g': 1.0 + nrm(ks[1], (DEPTH, D_MODEL), 0.02),
        'w_in': nrm(ks[2], (DEPTH, D_MODEL, N_IN), D_MODEL ** -0.5),
        'b_in': b_in,
        'mlstm_conv_w': nrm(ks[4], (DEPTH, MLSTM_CONV, 2 * MLSTM_DQK), MLSTM_CONV ** -0.5),
        'mlstm_conv_b': nrm(ks[5], (DEPTH, 2 * MLSTM_DQK), 0.02),
        'gla_gate_w': nrm(ks[6], (DEPTH, GLA_GATE_RANK, GLA_DK), GLA_GATE_RANK ** -0.5),
        'gla_gate_b': nrm(ks[7], (DEPTH, GLA_DK), 0.02),
        'gla_norm_g': 1.0 + nrm(ks[8], (DEPTH, GLA_DV), 0.02),
        'w_up_moba': nrm(ks[9], (DEPTH, MIX, D_MODEL), MIX ** -0.5),
        'w_up_gla': nrm(ks[10], (DEPTH, MIX, D_MODEL), MIX ** -0.5),
        'w_up_mlstm': nrm(ks[11], (DEPTH, MIX, D_MODEL), MIX ** -0.5),
        'w_o': nrm(ks[12], (DEPTH, D_MODEL, D_MODEL), D_MODEL ** -0.5),
        'ffn_norm_g': 1.0 + nrm(ks[13], (DEPTH, D_MODEL), 0.02),
        'ffn_w_gate': nrm(ks[14], (n_dense, D_MODEL, D_FF), D_MODEL ** -0.5),
        'ffn_w_up': nrm(ks[15], (n_dense, D_MODEL, D_FF), D_MODEL ** -0.5),
        'ffn_w_down': nrm(ks[16], (n_dense, D_FF, D_MODEL), D_FF ** -0.5),
        'router_w': nrm(ks[17], (n_moe, D_MODEL, N_EXPERTS), D_MODEL ** -0.5),
        'router_b': nrm(ks[18], (n_moe, N_EXPERTS), 0.01),
        'moe_w_gate': nrm(ks[19], (n_moe, N_EXPERTS, D_MODEL, D_FF), D_MODEL ** -0.5),
        'moe_w_up': nrm(ks[20], (n_moe, N_EXPERTS, D_MODEL, D_FF), D_MODEL ** -0.5),
        'moe_w_down': nrm(ks[21], (n_moe, N_EXPERTS, D_FF, D_MODEL), D_FF ** -0.5),
        'final_norm_g': 1.0 + nrm(ks[22], (D_MODEL,), 0.02),
    }


def reference(x, attn_norm_g, w_in, b_in, mlstm_conv_w, mlstm_conv_b, gla_gate_w, gla_gate_b,
              gla_norm_g, w_up_moba, w_up_gla, w_up_mlstm, w_o, ffn_norm_g, ffn_w_gate, ffn_w_up,
              ffn_w_down, router_w, router_b, moe_w_gate, moe_w_up, moe_w_down, final_norm_g):
    for l in range(DEPTH):
        h = rmsnorm(x, attn_norm_g[l])
        x = x + hybrid_mixer(h, w_in[l], b_in[l], mlstm_conv_w[l], mlstm_conv_b[l], gla_gate_w[l],
                             gla_gate_b[l], gla_norm_g[l], w_up_moba[l], w_up_gla[l], w_up_mlstm[l], w_o[l])
        h = rmsnorm(x, ffn_norm_g[l])
        j = l // 2
        if l % 2 == 0:
            x = x + swiglu(h, ffn_w_gate[j], ffn_w_up[j], ffn_w_down[j])
        else:
            x = x + moe_swiglu(h, router_w[j], router_b[j], moe_w_gate[j], moe_w_up[j], moe_w_down[j])
    return rmsnorm(x, final_norm_g)
```

```cpp
#include <hip/hip_runtime.h>
#include <hip/hip_bf16.h>
#include <stdint.h>
#include <cstdio>
#include <cmath>

typedef unsigned short bf16_t;
#define DEV __device__ __forceinline__
#define LAS __attribute__((address_space(3)))
#define GAS __attribute__((address_space(1)))

constexpr int T = 16384, SEQ = 8192, D = 1024, NIN = 8216, DFF = 2816;
constexpr int ZA_LD = 5120, ZG_LD = 3072;
constexpr int ZA_MQ = 0, ZA_MK = 512, ZA_MV = 1024, ZA_GQ = 1536, ZA_GK = 1792, ZA_GV = 2048, ZA_GR = 2560, ZA_LQ = 3072, ZA_LK = 3584, ZA_LV = 4096, ZA_LO = 4608;
constexpr float EPS = 1e-6f;
constexpr int MOE_ROWS = 34816;
constexpr int NWAVES = 8, NTHREADS = 512;

constexpr size_t MiB = 1u << 20;
constexpr size_t WS_CTL = 0, CTL_ZERO_BYTES = 64 * 1024;
constexpr size_t WS_ROPE_COS = 1 * MiB, WS_ROPE_SIN = 1 * MiB + 256 * 1024, WS_KM = 1 * MiB + 512 * 1024, WS_DEN = 1 * MiB + 640 * 1024;
constexpr size_t WS_TOPE = 2 * MiB, WS_TOPG = 2 * MiB + 128 * 1024, WS_SLOT = 2 * MiB + 256 * 1024, WS_ROWS_TOK = 2 * MiB + 384 * 1024, WS_ROWS_G = 2 * MiB + 640 * 1024,
                 WS_BLK_E = 2 * MiB + 896 * 1024, WS_NBLK = 2 * MiB + 900 * 1024;
constexpr size_t WS_RS = 3 * MiB, WS_RSG = 3 * MiB + 256 * 1024;
constexpr size_t WS_ZS = 4 * MiB;
constexpr size_t WS_WIN = 6 * MiB;
constexpr size_t WS_WUP = 38 * MiB;
constexpr size_t WS_WO3 = 44 * MiB;
constexpr size_t WS_WFGU = 56 * MiB;
constexpr size_t WS_WFD = 67 * MiB;
constexpr size_t WS_XN = 73 * MiB;
constexpr size_t WS_ZG = 201 * MiB;
constexpr size_t WS_ZA = 201 * MiB;
constexpr size_t WS_U = 297 * MiB;
constexpr size_t WS_HD = 201 * MiB;
constexpr size_t WS_Y012 = 361 * MiB;
constexpr size_t WS_MGU = 6 * MiB;
constexpr size_t WS_MD = 94 * MiB;
constexpr size_t WS_XN2 = 138 * MiB;
constexpr size_t WS_HM = 170 * MiB;
constexpr size_t WS_YM = 357 * MiB;
constexpr size_t WS_CQK2 = 105 * MiB;
constexpr size_t WS_UG = 137 * MiB;
constexpr size_t WS_UG2 = 153 * MiB;
constexpr size_t WS_DEC = 185 * MiB;
constexpr size_t WS_NU = 185 * MiB + 256 * 1024;
constexpr size_t WS_BL = 185 * MiB + 768 * 1024, WS_AMAX = WS_BL + 4096, WS_MPREV = WS_AMAX + 4096;
constexpr size_t WS_XB = 409 * MiB;
constexpr size_t WS_END = 441 * MiB;
constexpr int CW_TMO = 0, CW_BAR = 4096, CW_MOECNT = 2048, CW_WAMAX = 1024;

constexpr int RING_BYTES = 131072, LDSCTL_OFF = RING_BYTES, MISC_OFF = LDSCTL_OFF + 320, LDS_BYTES = 147456;

DEV float bf2f(bf16_t v) { return __uint_as_float((unsigned)v << 16); }
typedef float f32x2c_t __attribute__((ext_vector_type(2))); typedef __bf16 bf16x2c_t __attribute__((ext_vector_type(2)));
DEV unsigned cvt2bf(float lo, float hi) { const f32x2c_t v = {lo, hi}; return __builtin_bit_cast(unsigned, __builtin_convertvector(v, bf16x2c_t)); }
DEV unsigned pk4_fp8(float a, float b, float c, float d) {
    a = __builtin_amdgcn_fmed3f(a, -448.f, 448.f); b = __builtin_amdgcn_fmed3f(b, -448.f, 448.f); c = __builtin_amdgcn_fmed3f(c, -448.f, 448.f); d = __builtin_amdgcn_fmed3f(d, -448.f, 448.f);
    int w = __builtin_amdgcn_cvt_pk_fp8_f32(a, b, 0, false); w = __builtin_amdgcn_cvt_pk_fp8_f32(c, d, w, true); return (unsigned)w; }
DEV float pow2_scale(float amax) { return amax > 0.f ? exp2f(floorf(__log2f(192.f / amax))) : 1.f; }
DEV bf16_t f2bf(float f) { return (bf16_t)(cvt2bf(f, 0.f) & 0xffffu); }
DEV float sigmoidf_(float x) { return __builtin_amdgcn_rcpf(1.f + __expf(-x)); }
DEV float siluf_(float x) { return x * sigmoidf_(x); }
DEV float logsigmoidf_(float x) { return fminf(x, 0.f) - 0.6931471805599453f * __log2f(1.f + __expf(-fabsf(x))); }
#define DPPF(old_, v_, ctrl_, rm_) __builtin_bit_cast(float, __builtin_amdgcn_update_dpp(__builtin_bit_cast(int, (float)(old_)), __builtin_bit_cast(int, (float)(v_)), (ctrl_), (rm_), 0xf, false))
DEV float scan_add(float v, int) {
    v += DPPF(0.f, v, 0x111, 0xf); v += DPPF(0.f, v, 0x112, 0xf); v += DPPF(0.f, v, 0x114, 0xf); v += DPPF(0.f, v, 0x118, 0xf);
    v += DPPF(0.f, v, 0x142, 0xa); v += DPPF(0.f, v, 0x143, 0xc); return v;
}
DEV float scan_max(float v, int) {
    const float ni = -INFINITY;
    v = fmaxf(v, DPPF(ni, v, 0x111, 0xf)); v = fmaxf(v, DPPF(ni, v, 0x112, 0xf)); v = fmaxf(v, DPPF(ni, v, 0x114, 0xf)); v = fmaxf(v, DPPF(ni, v, 0x118, 0xf));
    v = fmaxf(v, DPPF(ni, v, 0x142, 0xa)); v = fmaxf(v, DPPF(ni, v, 0x143, 0xc)); return v;
}
DEV float wave_sum(float v) { return __builtin_bit_cast(float, __builtin_amdgcn_readlane(__builtin_bit_cast(int, scan_add(v, 0)), 63)); }
DEV float wave_max(float v) { return __builtin_bit_cast(float, __builtin_amdgcn_readlane(__builtin_bit_cast(int, scan_max(v, 0)), 63)); }

namespace pg8 {
#define PG8_LAS __attribute__((address_space(3)))
typedef short bf16x8 __attribute__((ext_vector_type(8)));
typedef float f32x4 __attribute__((ext_vector_type(4)));
typedef unsigned u32x4 __attribute__((ext_vector_type(4)));
constexpr int BM = 256, BK = 64, HALF = 128, HTB = HALF * BK * 2, STAGE_BYTES = 8 * HTB, NXCD = 8, WGM = 8;
__host__ __device__ __forceinline__ int lds_byte(int r, int c) { const int st = (r >> 4) * 2 + (c >> 5), rr = r & 15, cc = c & 31, ob = rr * 64 + cc * 2; return st * 1024 + (ob ^ (((ob >> 9) & 1) << 5)); }
__host__ __device__ __forceinline__ void stage_rc(int b, int& R, int& C) { const int st = b / 1024, sb = b % 1024, swz = sb ^ (((sb >> 9) & 1) << 5); R = (st >> 1) * 16 + swz / 64; C = (st & 1) * 32 + (swz % 64) / 2; }
__host__ __device__ __forceinline__ int perm32(int rho) { const int n = rho >> 4, i = rho & 15; return 8 * (i >> 2) + 4 * n + (i & 3); }

struct Unit { int pm, pn; const char* a; const char* b; int kh, q, hm; };
struct Sched {
    int nM, nN, nwg, G, c, pn0, branch3, first, lim, nsplit, nhalf; unsigned kbytes;
    const char* A; size_t a_tile; int a_split_tiles; size_t a_split_bytes;
    const char* B; size_t b_tile; const int* blk_e; size_t b_estride;
    __device__ __forceinline__ void init(int nM_, int nN_, int G_, int c_, const void* A_, int lda, const void* B_, int ldb) {
        nM = nM_; nN = nN_; nwg = nM * nN; G = G_; c = c_; pn0 = 0; branch3 = 0; first = 0; lim = nM_ * nN_; nsplit = 0; nhalf = 0; kbytes = 0u; A = (const char*)A_; a_tile = (size_t)BM * lda * 2; a_split_tiles = 0; a_split_bytes = 0;
        B = (const char*)B_; b_tile = (size_t)BM * ldb * 2; blk_e = nullptr; b_estride = 0; }
    __device__ __forceinline__ bool next(int i, Unit& u) const {
        long L; u.kh = 0; u.q = 0; u.hm = 0;
        if (nhalf > 0) { if (i > 0 || c >= 2 * nhalf) return false; L = first + (c >> 1); u.hm = 1 + (c & 1); } else
        if (nsplit > 0) { if (i > 0 || c >= 2 * nsplit) return false; L = first + (c >> 1); u.kh = c & 1; u.q = c >> 1; }
        else { L = branch3 ? (long)c : (long)first + (long)i * G + c; if (L >= lim || (branch3 && i >= 3)) return false; }
        int wgid = (int)L; { const int q = nwg / NXCD, r = nwg % NXCD, xcd = wgid % NXCD, off = wgid / NXCD; wgid = (xcd < r ? xcd * (q + 1) : r * (q + 1) + (xcd - r) * q) + off; }
        const int nig = WGM * nN, gid = wgid / nig, fm = gid * WGM, gsz = (nM - fm) < WGM ? (nM - fm) : WGM;
        u.pm = fm + ((wgid % nig) % gsz); u.pn = pn0 + (wgid % nig) / gsz + (branch3 ? 4 * i : 0);
        u.a = A + (size_t)u.pm * a_tile + (a_split_tiles ? (size_t)(u.pn / a_split_tiles) * a_split_bytes : 0);
        u.b = B + (size_t)u.pn * b_tile + (blk_e ? (size_t)blk_e[u.pm] * b_estride : 0);
        if (u.kh) { u.a += kbytes; u.b += kbytes; }
        if (u.hm == 2) u.a += (a_tile >> 1);
        return true;
    }
    __device__ __forceinline__ void a_ready(const Unit&) const {}
    __device__ __forceinline__ void done(const Unit&) const {}
};

__device__ __forceinline__ unsigned cvt_pk_bf16(float lo, float hi) { unsigned r; asm volatile("v_cvt_pk_bf16_f32 %0, %1, %2" : "=v"(r) : "v"(lo), "v"(hi)); return r; }
__device__ __forceinline__ float fsig(float x) { return __builtin_amdgcn_rcpf(1.f + __expf(-x)); }
__device__ __forceinline__ f32x4 unpk_lo(unsigned a, unsigned b) { return (f32x4){__uint_as_float(a << 16), __uint_as_float(a & 0xffff0000u), __uint_as_float(b << 16), __uint_as_float(b & 0xffff0000u)}; }
struct EpiInproj {
    static constexpr bool PERM = true, AFTER_DRAIN = false;
    bf16_t* ZA; bf16_t* ZG; const float* bias;
    __device__ __forceinline__ void operator()(const f32x4 (&acc)[2][2][4][2], const Unit& u, int wr, int wc, int fr, int fq) const {
        const int row0 = u.pm * BM + wr * 64 + fr, colt = u.pn * BM, shift = colt >= 4608 ? 24 : (colt >= 2560 ? 16 : 0), lc = wc * 32 + 8 * fq;
        bf16_t* base = colt < ZA_LD ? ZA : ZG; const int ld = colt < ZA_LD ? ZA_LD : ZG_LD, cb = colt < ZA_LD ? colt : colt - ZA_LD;
        f32x4 bv[2][2];
#pragma unroll
        for (int bj = 0; bj < 2; ++bj)
#pragma unroll
            for (int n = 0; n < 2; ++n) bv[bj][n] = *(const f32x4*)(bias + colt + shift + bj * HALF + lc + 4 * n);
#pragma unroll
        for (int ai = 0; ai < 2; ++ai)
#pragma unroll
            for (int m = 0; m < 4; ++m) { bf16_t* rowp = base + (size_t)(row0 + ai * HALF + m * 16) * ld + cb + lc;
#pragma unroll
                for (int bj = 0; bj < 2; ++bj) { const f32x4 v0 = acc[ai][bj][m][0] + bv[bj][0], v1 = acc[ai][bj][m][1] + bv[bj][1];
                    u32x4 w; w.x = cvt_pk_bf16(v0[0], v0[1]); w.y = cvt_pk_bf16(v0[2], v0[3]); w.z = cvt_pk_bf16(v1[0], v1[1]); w.w = cvt_pk_bf16(v1[2], v1[3]);
                    *(u32x4*)(rowp + bj * HALF) = w; } }
    }
};
struct EpiUpGate {
    static constexpr bool PERM = true, AFTER_DRAIN = false;
    bf16_t* M; const bf16_t* ZG;
    __device__ __forceinline__ void operator()(const f32x4 (&acc)[2][2][4][2], const Unit& u, int wr, int wc, int fr, int fq) const {
        const int row0 = u.pm * BM + wr * 64 + fr, gcol0 = u.pn * BM + wc * 32 + 8 * fq, mcol0 = (u.pn & 3) * BM + wc * 32 + 8 * fq; const bool first = (u.pn >> 2) == 0;
#pragma unroll
        for (int ai = 0; ai < 2; ++ai) { u32x4 gw[4][2], pw[4][2];
#pragma unroll
            for (int m = 0; m < 4; ++m)
#pragma unroll
                for (int bj = 0; bj < 2; ++bj) { gw[m][bj] = *(const u32x4*)(ZG + (size_t)(row0 + ai * HALF + m * 16) * ZG_LD + gcol0 + bj * HALF);
                    if (!first) pw[m][bj] = *(const u32x4*)(M + (size_t)(row0 + ai * HALF + m * 16) * D + mcol0 + bj * HALF); }
            asm volatile("" ::: "memory");
#pragma unroll
            for (int m = 0; m < 4; ++m)
#pragma unroll
                for (int bj = 0; bj < 2; ++bj) { const f32x4 g0 = unpk_lo(gw[m][bj].x, gw[m][bj].y), g1 = unpk_lo(gw[m][bj].z, gw[m][bj].w); f32x4 v0 = acc[ai][bj][m][0], v1 = acc[ai][bj][m][1];
#pragma unroll
                    for (int j = 0; j < 4; ++j) { v0[j] *= fsig(g0[j]); v1[j] *= fsig(g1[j]); }
                    if (!first) { v0 += unpk_lo(pw[m][bj].x, pw[m][bj].y); v1 += unpk_lo(pw[m][bj].z, pw[m][bj].w); }
                    u32x4 w; w.x = cvt_pk_bf16(v0[0], v0[1]); w.y = cvt_pk_bf16(v0[2], v0[3]); w.z = cvt_pk_bf16(v1[0], v1[1]); w.w = cvt_pk_bf16(v1[2], v1[3]);
                    *(u32x4*)(M + (size_t)(row0 + ai * HALF + m * 16) * D + mcol0 + bj * HALF) = w; }
            asm volatile("" ::: "memory"); }
    }
};
template <bool BASE_BF16, bool OUT_BF16>
struct EpiResidT {
    static constexpr bool PERM = false, AFTER_DRAIN = false;
    const void* base; void* out;
    __device__ __forceinline__ void operator()(const f32x4 (&acc)[2][2][4][2], const Unit& u, int wr, int wc, int fr, int fq) const {
        const int row0 = u.pm * BM + wr * 64 + fr, col0 = u.pn * BM + wc * 32 + 4 * fq;
#pragma unroll
        for (int ai = 0; ai < 2; ++ai) { f32x4 b[4][2][2];
#pragma unroll
            for (int m = 0; m < 4; ++m)
#pragma unroll
                for (int bj = 0; bj < 2; ++bj)
#pragma unroll
                    for (int n = 0; n < 2; ++n) { const size_t o2 = (size_t)(row0 + ai * HALF + m * 16) * D + col0 + bj * HALF + n * 16;
                        if (BASE_BF16) { const uint2 w = *(const uint2*)((const bf16_t*)base + o2); b[m][bj][n] = unpk_lo(w.x, w.y); } else b[m][bj][n] = *(const f32x4*)((const float*)base + o2); }
            asm volatile("" ::: "memory");
#pragma unroll
            for (int m = 0; m < 4; ++m)
#pragma unroll
                for (int bj = 0; bj < 2; ++bj)
#pragma unroll
                    for (int n = 0; n < 2; ++n) { const size_t o2 = (size_t)(row0 + ai * HALF + m * 16) * D + col0 + bj * HALF + n * 16; const f32x4 v = b[m][bj][n] + acc[ai][bj][m][n];
                        if (OUT_BF16) { uint2 w; w.x = cvt_pk_bf16(v[0], v[1]); w.y = cvt_pk_bf16(v[2], v[3]); *(uint2*)((bf16_t*)out + o2) = w; } else *(f32x4*)((float*)out + o2) = v; }
            asm volatile("" ::: "memory"); }
    }
};
struct EpiSwiglu {
    static constexpr bool PERM = true, AFTER_DRAIN = false;
    bf16_t* H;
    __device__ __forceinline__ void operator()(const f32x4 (&acc)[2][2][4][2], const Unit& u, int wr, int wc, int fr, int fq) const {
        const int row0 = u.pm * BM + (u.hm == 2 ? HALF : 0) + wr * 64 + fr, col0 = u.pn * HALF + wc * 32 + 8 * fq;
#pragma unroll
        for (int ai = 0; ai < 2; ++ai) if (ai == 0 || u.hm == 0)
#pragma unroll
            for (int m = 0; m < 4; ++m) { f32x4 v0, v1;
#pragma unroll
                for (int j = 0; j < 4; ++j) { const float a0 = acc[ai][0][m][0][j], a1 = acc[ai][0][m][1][j]; v0[j] = a0 * fsig(a0) * acc[ai][1][m][0][j]; v1[j] = a1 * fsig(a1) * acc[ai][1][m][1][j]; }
                u32x4 w; w.x = cvt_pk_bf16(v0[0], v0[1]); w.y = cvt_pk_bf16(v0[2], v0[3]); w.z = cvt_pk_bf16(v1[0], v1[1]); w.w = cvt_pk_bf16(v1[2], v1[3]);
                *(u32x4*)(H + (size_t)(row0 + ai * HALF + m * 16) * DFF + col0) = w; }
    }
};
struct EpiSwigluQ {
    static constexpr bool PERM = true, AFTER_DRAIN = false;
    bf16_t* H; const float* rs; float cg, cu;
    __device__ __forceinline__ void operator()(const f32x4 (&acc)[2][2][4][2], const Unit& u, int wr, int wc, int fr, int fq) const {
        const int row0 = u.pm * BM + (u.hm == 2 ? HALF : 0) + wr * 64 + fr, col0 = u.pn * HALF + wc * 32 + 8 * fq;
        float rr[2][4];
#pragma unroll
        for (int ai = 0; ai < 2; ++ai)
#pragma unroll
            for (int m = 0; m < 4; ++m) rr[ai][m] = (ai == 0 || u.hm == 0) ? rs[row0 + ai * HALF + m * 16] : 0.f;
        asm volatile("" ::: "memory");
#pragma unroll
        for (int ai = 0; ai < 2; ++ai) if (ai == 0 || u.hm == 0)
#pragma unroll
            for (int m = 0; m < 4; ++m) { f32x4 v0, v1; const float r_ = rr[ai][m], sg = r_ * cg, su = r_ * cu;
#pragma unroll
                for (int j = 0; j < 4; ++j) { const float a0 = acc[ai][0][m][0][j] * sg, a1 = acc[ai][0][m][1][j] * sg; v0[j] = a0 * fsig(a0) * (acc[ai][1][m][0][j] * su); v1[j] = a1 * fsig(a1) * (acc[ai][1][m][1][j] * su); }
                int w0 = __builtin_amdgcn_cvt_pk_bf8_f32(v0[0], v0[1], 0, false); w0 = __builtin_amdgcn_cvt_pk_bf8_f32(v0[2], v0[3], w0, true);
                int w1 = __builtin_amdgcn_cvt_pk_bf8_f32(v1[0], v1[1], 0, false); w1 = __builtin_amdgcn_cvt_pk_bf8_f32(v1[2], v1[3], w1, true);
                uint2 w; w.x = (unsigned)w0; w.y = (unsigned)w1; *(uint2*)((unsigned char*)H + (size_t)(row0 + ai * HALF + m * 16) * DFF + col0) = w; }
    }
};
struct EpiStoreQ {
    static constexpr bool PERM = true, AFTER_DRAIN = false;
    bf16_t* O; float cd;
    __device__ __forceinline__ void operator()(const f32x4 (&acc)[2][2][4][2], const Unit& u, int wr, int wc, int fr, int fq) const {
        const int row0 = u.pm * BM + (u.hm == 2 ? HALF : 0) + wr * 64 + fr, col0 = u.pn * BM + wc * 32 + 8 * fq;
#pragma unroll
        for (int ai = 0; ai < 2; ++ai) if (ai == 0 || u.hm == 0)
#pragma unroll
            for (int m = 0; m < 4; ++m)
#pragma unroll
                for (int bj = 0; bj < 2; ++bj) { const f32x4 v0 = acc[ai][bj][m][0] * cd, v1 = acc[ai][bj][m][1] * cd;
                    u32x4 w; w.x = cvt_pk_bf16(v0[0], v0[1]); w.y = cvt_pk_bf16(v0[2], v0[3]); w.z = cvt_pk_bf16(v1[0], v1[1]); w.w = cvt_pk_bf16(v1[2], v1[3]);
                    *(u32x4*)(O + (size_t)(row0 + ai * HALF + m * 16) * D + col0 + bj * HALF) = w; }
    }
};
struct EpiStore {
    static constexpr bool PERM = true, AFTER_DRAIN = false;
    bf16_t* O; bf16_t* OB;
    __device__ __forceinline__ void operator()(const f32x4 (&acc)[2][2][4][2], const Unit& u, int wr, int wc, int fr, int fq) const {
        if (u.kh) { bf16_t* T = OB + (size_t)u.q * 65536; const int r0 = wr * 64 + fr, c0 = wc * 32 + 8 * fq;
#pragma unroll
            for (int ai = 0; ai < 2; ++ai)
#pragma unroll
                for (int m = 0; m < 4; ++m)
#pragma unroll
                    for (int bj = 0; bj < 2; ++bj) { const f32x4 v0 = acc[ai][bj][m][0], v1 = acc[ai][bj][m][1];
                        u32x4 w; w.x = cvt_pk_bf16(v0[0], v0[1]); w.y = cvt_pk_bf16(v0[2], v0[3]); w.z = cvt_pk_bf16(v1[0], v1[1]); w.w = cvt_pk_bf16(v1[2], v1[3]);
                        *(u32x4*)(T + (size_t)(r0 + ai * HALF + m * 16) * 256 + c0 + bj * HALF) = w; }
            return; }
        const int row0 = u.pm * BM + wr * 64 + fr, col0 = u.pn * BM + wc * 32 + 8 * fq;
#pragma unroll
        for (int ai = 0; ai < 2; ++ai)
#pragma unroll
            for (int m = 0; m < 4; ++m)
#pragma unroll
                for (int bj = 0; bj < 2; ++bj) { const f32x4 v0 = acc[ai][bj][m][0], v1 = acc[ai][bj][m][1];
                    u32x4 w; w.x = cvt_pk_bf16(v0[0], v0[1]); w.y = cvt_pk_bf16(v0[2], v0[3]); w.z = cvt_pk_bf16(v1[0], v1[1]); w.w = cvt_pk_bf16(v1[2], v1[3]);
                    *(u32x4*)(O + (size_t)(row0 + ai * HALF + m * 16) * D + col0 + bj * HALF) = w; }
    }
};

typedef int v8i_t __attribute__((ext_vector_type(8)));
typedef int v4i_t __attribute__((ext_vector_type(4)));
__device__ __forceinline__ v8i_t cat8(bf16x8 a, bf16x8 b) { const v4i_t x = __builtin_bit_cast(v4i_t, a), y = __builtin_bit_cast(v4i_t, b); return __builtin_shufflevector(x, y, 0, 1, 2, 3, 4, 5, 6, 7); }
template <int F8> __device__ __forceinline__ void mfma_q8(f32x4& c, const v8i_t a, const v8i_t b) {
    if constexpr (F8 == 2) asm volatile("v_mfma_f32_16x16x128_f8f6f4 %0, %1, %2, %0 blgp:1" : "+v"(c) : "v"(a), "v"(b));
    else asm volatile("v_mfma_f32_16x16x128_f8f6f4 %0, %1, %2, %0" : "+v"(c) : "v"(a), "v"(b)); }
template <class Epi, class Sched, bool ALIGN_EPI = false, bool SP2 = false, bool HALFM = false, int F8 = 0>
__device__ __forceinline__ void gemm_phase(PG8_LAS unsigned char* lds, const int tid, const int lda, const int ldb, const int K, const Sched& S, const Epi& E) {
    const int wid = __builtin_amdgcn_readfirstlane(tid >> 6), lane = tid & 63, wr = wid >> 2, wc = wid & 3, fr = lane & 15, fq = lane >> 4;
    const int nt = K / BK;
    unsigned voffA[2], voffB[2];
#pragma unroll
    for (int i = 0; i < 2; ++i) { int R, C; stage_rc(tid * 16 + i * 8192, R, C); const int Rb = Epi::PERM ? ((R & ~31) + perm32(R & 31)) : R;
        voffA[i] = (unsigned)(R * lda + C) * 2u; voffB[i] = (unsigned)(Rb * ldb + C) * 2u; }
    const size_t kstep = (size_t)(BK * 2);
    const size_t hstepA = (size_t)HALF * lda * 2, hstepB = (size_t)HALF * ldb * 2;
    const unsigned ldsw = (unsigned)wid * 1024u;
    const int aoff = lds_byte(wr * 64 + fr, fq * 8), boff = lds_byte(wc * 32 + fr, fq * 8);
#define PG8_SA(b, h) (((b) * 2 + (h)) * HTB)
#define PG8_SB(b, h) ((4 + (b) * 2 + (h)) * HTB)
#define PG8_STAGE(bufoff, gbase, voff) do { _Pragma("unroll") for (int _i = 0; _i < 2; ++_i) \
        __builtin_amdgcn_global_load_lds((const unsigned*)((const char*)(gbase) + (voff)[_i]), (PG8_LAS unsigned*)(lds + (bufoff) + ldsw + _i * 8192), 16, 0, 0); } while (0)
#define PG8_LDA(dst, b, h) do { _Pragma("unroll") for (int m = 0; m < 4; ++m) _Pragma("unroll") for (int k = 0; k < 2; ++k) dst[m][k] = *(const PG8_LAS bf16x8*)(lds + PG8_SA(b, h) + aoff + m * 2048 + k * 1024); } while (0)
#define PG8_LDB(dst, b, h) do { _Pragma("unroll") for (int n = 0; n < 2; ++n) _Pragma("unroll") for (int k = 0; k < 2; ++k) dst[n][k] = *(const PG8_LAS bf16x8*)(lds + PG8_SB(b, h) + boff + n * 2048 + k * 1024); } while (0)
#define PG8_MMA(ai, bj, At, Bt) do { __builtin_amdgcn_s_setprio(1); _Pragma("unroll") for (int m = 0; m < 4; ++m) _Pragma("unroll") for (int n = 0; n < 2; ++n) { \
        if constexpr (F8 != 0) mfma_q8<F8>(acc[ai][bj][m][n], cat8(Bt[n][0], Bt[n][1]), cat8(At[m][0], At[m][1])); \
        else { _Pragma("unroll") for (int k = 0; k < 2; ++k) acc[ai][bj][m][n] = __builtin_amdgcn_mfma_f32_16x16x32_bf16(Bt[n][k], At[m][k], acc[ai][bj][m][n], 0, 0, 0); } } __builtin_amdgcn_s_setprio(0); } while (0)
#define PG8_WAIT_V(n) asm volatile("s_waitcnt vmcnt(" #n ")" ::: "memory")
#define PG8_WAIT_L(n) asm volatile("s_waitcnt lgkmcnt(" #n ")" ::: "memory")
#define PG8_BAR __builtin_amdgcn_s_barrier()
#define PG8_SCHED __builtin_amdgcn_sched_barrier(0)
    Unit cur, nxt; int ui = 0;
    if (!S.next(0, cur)) return;
    f32x4 acc[2][2][4][2];
#pragma unroll
    for (int a = 0; a < 2; ++a)
#pragma unroll
        for (int b = 0; b < 2; ++b)
#pragma unroll
            for (int m = 0; m < 4; ++m)
#pragma unroll
                for (int n = 0; n < 2; ++n) acc[a][b][m][n] = (f32x4){0.f, 0.f, 0.f, 0.f};
    bf16x8 At[4][2], B0[2][2], B1[2][2];
    const char* cA = cur.a; const char* cB = cur.b;
    S.a_ready(cur);
    if constexpr (SP2) {
        PG8_STAGE(PG8_SB(0, 0), cB, voffB); PG8_STAGE(PG8_SB(0, 1), cB + hstepB, voffB); PG8_STAGE(PG8_SA(0, 0), cA, voffA); PG8_STAGE(PG8_SA(0, 1), cA + hstepA, voffA);
        if (wr == 1) PG8_BAR;
        PG8_WAIT_V(2); PG8_BAR;
        PG8_STAGE(PG8_SB(1, 0), cB + kstep, voffB); PG8_STAGE(PG8_SA(1, 0), cA + kstep, voffA); PG8_STAGE(PG8_SB(1, 1), cB + hstepB + kstep, voffB);
        PG8_WAIT_V(6); PG8_BAR;
    } else {
        PG8_STAGE(PG8_SB(0, 0), cB, voffB); PG8_STAGE(PG8_SA(0, 0), cA, voffA); PG8_STAGE(PG8_SB(0, 1), cB + hstepB, voffB); PG8_STAGE(PG8_SA(0, 1), cA + hstepA, voffA);
        if (wr == 1) PG8_BAR;
        PG8_WAIT_V(4); PG8_BAR;
        PG8_STAGE(PG8_SB(1, 0), cB + kstep, voffB); PG8_STAGE(PG8_SA(1, 0), cA + kstep, voffA); PG8_STAGE(PG8_SB(1, 1), cB + hstepB + kstep, voffB);
        PG8_WAIT_V(6); PG8_BAR;
    }
    for (;;) {
        const bool has_next = S.next(ui + 1, nxt);
        const char* nA = has_next ? nxt.a : cA; const char* nB = has_next ? nxt.b : cB;
        for (int t = 0; t < nt; t += 2) {
            const bool last = (t == nt - 2);
            const char* a1 = cA + (size_t)(t + 1) * kstep;
            const char* a2 = last ? nA : cA + (size_t)(t + 2) * kstep; const char* b2 = last ? nB : cB + (size_t)(t + 2) * kstep;
            const char* a3 = a2 + kstep; const char* b3 = b2 + kstep;
            if (last && has_next) S.a_ready(nxt);
            if constexpr (SP2) {
            PG8_LDB(B0, 0, 0); PG8_LDB(B1, 0, 1); PG8_SCHED; PG8_LDA(At, 0, 0); PG8_STAGE(PG8_SA(1, 1), a1 + hstepA, voffA);
            PG8_WAIT_V(8); PG8_WAIT_L(0); PG8_BAR; PG8_MMA(0, 0, At, B0); PG8_MMA(0, 1, At, B1); PG8_BAR; PG8_SCHED;
            if (!HALFM) PG8_LDA(At, 0, 1); PG8_STAGE(PG8_SB(0, 0), b2, voffB); PG8_STAGE(PG8_SB(0, 1), b2 + hstepB, voffB); PG8_STAGE(PG8_SA(0, 0), a2, voffA);
            PG8_WAIT_V(8); PG8_WAIT_L(0); PG8_BAR; if (!HALFM) { PG8_MMA(1, 0, At, B0); PG8_MMA(1, 1, At, B1); } PG8_BAR; PG8_SCHED;
            PG8_LDB(B0, 1, 0); PG8_LDB(B1, 1, 1); PG8_SCHED; PG8_LDA(At, 1, 0); PG8_STAGE(PG8_SA(0, 1), a2 + hstepA, voffA);
            PG8_WAIT_V(8); PG8_WAIT_L(0); PG8_BAR; PG8_MMA(0, 0, At, B0); PG8_MMA(0, 1, At, B1); PG8_BAR; PG8_SCHED;
            if (!HALFM) PG8_LDA(At, 1, 1); PG8_STAGE(PG8_SB(1, 0), b3, voffB); PG8_STAGE(PG8_SB(1, 1), b3 + hstepB, voffB); PG8_STAGE(PG8_SA(1, 0), a3, voffA);
            PG8_WAIT_V(8); PG8_WAIT_L(0); PG8_BAR; if (!HALFM) { PG8_MMA(1, 0, At, B0); PG8_MMA(1, 1, At, B1); } PG8_BAR; PG8_SCHED;
            } else {
            PG8_LDB(B0, 0, 0); PG8_SCHED; PG8_LDA(At, 0, 0); PG8_STAGE(PG8_SA(1, 1), a1 + hstepA, voffA);
            PG8_WAIT_L(8); PG8_BAR; PG8_WAIT_L(0); PG8_MMA(0, 0, At, B0); PG8_BAR; PG8_SCHED;
            PG8_LDB(B1, 0, 1); PG8_STAGE(PG8_SB(0, 0), b2, voffB);
            PG8_BAR; PG8_WAIT_L(0); PG8_MMA(0, 1, At, B1); PG8_BAR;
            PG8_LDA(At, 0, 1); PG8_STAGE(PG8_SA(0, 0), a2, voffA);
            PG8_BAR; PG8_WAIT_L(0); PG8_MMA(1, 0, At, B0); PG8_BAR; PG8_SCHED;
            PG8_STAGE(PG8_SB(0, 1), b2 + hstepB, voffB);
            PG8_WAIT_V(6); PG8_BAR; PG8_MMA(1, 1, At, B1); PG8_BAR;
            PG8_LDB(B0, 1, 0); PG8_SCHED; PG8_LDA(At, 1, 0); PG8_STAGE(PG8_SA(0, 1), a2 + hstepA, voffA);
            PG8_WAIT_L(8); PG8_BAR; PG8_WAIT_L(0); PG8_MMA(0, 0, At, B0); PG8_BAR; PG8_SCHED;
            PG8_LDB(B1, 1, 1); PG8_STAGE(PG8_SB(1, 0), b3, voffB);
            PG8_BAR; PG8_WAIT_L(0); PG8_MMA(0, 1, At, B1); PG8_BAR;
            PG8_LDA(At, 1, 1); PG8_STAGE(PG8_SA(1, 0), a3, voffA);
            PG8_BAR; PG8_WAIT_L(0); PG8_MMA(1, 0, At, B0); PG8_BAR; PG8_SCHED;
            PG8_STAGE(PG8_SB(1, 1), b3 + hstepB, voffB);
            PG8_WAIT_V(6); PG8_BAR; PG8_MMA(1, 1, At, B1); PG8_BAR;
            }
        }
        if constexpr (ALIGN_EPI) { if (wr == 0) PG8_BAR; }
        if constexpr (F8 != 0) { asm volatile("s_nop 15\n\ts_nop 15\n\ts_nop 15" ::: "memory"); __builtin_amdgcn_sched_barrier(0); }
        if constexpr (!Epi::AFTER_DRAIN) { E(acc, cur, wr, wc, fr, fq); S.done(cur); }
        if (!has_next) break;
#pragma unroll
        for (int a = 0; a < 2; ++a)
#pragma unroll
            for (int b = 0; b < 2; ++b)
#pragma unroll
                for (int m = 0; m < 4; ++m)
#pragma unroll
                    for (int n = 0; n < 2; ++n) acc[a][b][m][n] = (f32x4){0.f, 0.f, 0.f, 0.f};
        cur = nxt; cA = nA; cB = nB; ++ui;
        if constexpr (ALIGN_EPI) { if (wr == 1) PG8_BAR; }
    }
    PG8_WAIT_V(0);
    if constexpr (!ALIGN_EPI) { if (wr == 0) PG8_BAR; }
    PG8_BAR;
    if constexpr (Epi::AFTER_DRAIN) { E.fused(acc, cur, wr, wc, fr, fq, lds, wid, lane); S.done(cur); }
#undef PG8_SA
#undef PG8_SB
#undef PG8_STAGE
#undef PG8_LDA
#undef PG8_LDB
#undef PG8_MMA
#undef PG8_WAIT_V
#undef PG8_WAIT_L
#undef PG8_BAR
#undef PG8_SCHED
}
}

#define XB_TMO      128
#define XB_XCNT(j)  (256  + 64 * (j))
#define XB_XSUB(j)  (1280 + 64 * (j))
#define XB_XGEN(j)  (2304 + 64 * (j))
#define XB_TOP      3328
#define XB_TOPGEN   3392
#define XCD_BAR_WORDS 3456
#define XB_SPIN_CAP (1u << 24)

__device__ __forceinline__ unsigned xb_ld(unsigned* p)              { return __hip_atomic_load(p, __ATOMIC_RELAXED, __HIP_MEMORY_SCOPE_AGENT); }
__device__ __forceinline__ unsigned xb_add(unsigned* p, unsigned v) { return __hip_atomic_fetch_add(p, v, __ATOMIC_RELAXED, __HIP_MEMORY_SCOPE_AGENT); }
__device__ __forceinline__ unsigned xb_xcc_id() { return (unsigned)__builtin_amdgcn_s_getreg((3 << 11) | 20) & 0xFu; }
#define XB_SPIN(cond, bar) do { unsigned _sp = 0; while (cond) { __builtin_amdgcn_s_sleep(1); \
    if ((++_sp & 255u) == 0u) { if (xb_ld(&(bar)[XB_TMO])) break; if (_sp > XB_SPIN_CAP) { atomicAdd(&(bar)[XB_TMO], 1u); break; } } } } while (0)

struct XcdBarrier {
    unsigned* bar; unsigned x;
    volatile LAS unsigned* st;
};

__device__ __forceinline__ XcdBarrier xcd_barrier_post(unsigned* bar, volatile LAS unsigned* st) {
    XcdBarrier b; b.bar = bar; b.x = xb_xcc_id(); b.st = st;
    if (threadIdx.x == 0) (void)xb_add(&bar[XB_XCNT(b.x)], 1u);
    return b;
}
__device__ __forceinline__ void xcd_barrier_complete(unsigned* bar, unsigned x, unsigned& nloc, unsigned& nx) {
    const unsigned G = gridDim.x * gridDim.y * gridDim.z;
    unsigned sum, cnt, mine, sp = 0u;
    for (;;) {
        sum = 0u; cnt = 0u; mine = 0u;
#pragma unroll
        for (unsigned j = 0; j < 16; ++j) { const unsigned c = xb_ld(&bar[XB_XCNT(j)]); sum += c; cnt += (c > 0u) ? 1u : 0u; mine = (j == x) ? c : mine; }
        if (sum == G) break;
        __builtin_amdgcn_s_sleep(1);
        if ((++sp & 255u) == 0u) { if (xb_ld(&bar[XB_TMO])) break; if (sp > XB_SPIN_CAP) { atomicAdd(&bar[XB_TMO], 1u); break; } }
    }
    nloc = mine > 0u ? mine : 1u; nx = cnt > 0u ? cnt : 1u;
}

__device__ __forceinline__ void xcd_barrier(const XcdBarrier& b) {
    asm volatile("s_waitcnt vmcnt(0)" ::: "memory");
    __syncthreads();
    if (threadIdx.x == 0) {
        unsigned* bar = b.bar;
        __builtin_amdgcn_s_waitcnt(0);
        unsigned nloc = b.st[0], nx = b.st[1];
        if (nloc == 0u) { xcd_barrier_complete(bar, b.x, nloc, nx); b.st[0] = nloc; b.st[1] = nx; }
        const unsigned old = xb_add(&bar[XB_XSUB(b.x)], 1u);
        const unsigned gen = old / nloc;
        if (old + 1u == (gen + 1u) * nloc) {
            __builtin_amdgcn_fence(__ATOMIC_RELEASE, "agent");
            asm volatile("s_waitcnt vmcnt(0)" ::: "memory");
            const unsigned og = xb_add(&bar[XB_TOP], 1u);
            const unsigned tg = og / nx;
            if (og + 1u == (tg + 1u) * nx) xb_add(&bar[XB_TOPGEN], 1u);
            else XB_SPIN(xb_ld(&bar[XB_TOPGEN]) == tg, bar);
            __builtin_amdgcn_fence(__ATOMIC_ACQUIRE, "agent");
            xb_add(&bar[XB_XGEN(b.x)], 1u);
            asm volatile("s_waitcnt vmcnt(0)" ::: "memory");
        } else {
            XB_SPIN(xb_ld(&bar[XB_XGEN(b.x)]) == gen, bar);
            __builtin_amdgcn_fence(__ATOMIC_ACQUIRE, "agent");
            asm volatile("s_waitcnt vmcnt(0)" ::: "memory");
        }
    }
    __syncthreads();
}
typedef GAS unsigned gu32;
#define RLX_AGENT __ATOMIC_RELAXED, __HIP_MEMORY_SCOPE_AGENT
#define LDS_WAIT() asm volatile("s_waitcnt lgkmcnt(0)" ::: "memory")
typedef float f32x4 __attribute__((ext_vector_type(4)));
typedef unsigned v4u __attribute__((ext_vector_type(4)));

struct Frame {
    LAS unsigned char* lds; unsigned char* ldsg;
    int tid, lane, wave, vcu, G, gw, NGW, bx;
    float* X; unsigned char* ws;
};
typedef short bf16x8 __attribute__((ext_vector_type(8)));
typedef short v4i16_t __attribute__((ext_vector_type(4)));
typedef float f32x16 __attribute__((ext_vector_type(16)));
__host__ __device__ __forceinline__ void unit_tile(int L, int nM, int nN, int& pm, int& pn) {
    const int nwg = nM * nN; int wgid = L; { const int q = nwg / 8, r = nwg % 8, xcd = wgid % 8, off = wgid / 8; wgid = (xcd < r ? xcd * (q + 1) : r * (q + 1) + (xcd - r) * q) + off; }
    const int nig = 8 * nN, gid = wgid / nig, fm = gid * 8, gsz = (nM - fm) < 8 ? (nM - fm) : 8; pm = fm + ((wgid % nig) % gsz); pn = (wgid % nig) / gsz;
}
DEV int crow(int reg, int hh) { return (reg & 3) + 8 * (reg >> 2) + 4 * hh; }
#define MFMA32(a, b, c) __builtin_amdgcn_mfma_f32_32x32x16_bf16((a), (b), (c), 0, 0, 0)
struct Args { const float* in[23]; float* out; unsigned char* ws; int ph_lo, ph_hi; };
typedef const __attribute__((address_space(4))) Args* CArgs;
DEV unsigned pk2(float lo, float hi) { return cvt2bf(lo, hi); }

DEV void unpack8(const v4u u, float (&f)[8]) { f[0] = __uint_as_float(u.x << 16); f[1] = __uint_as_float(u.x & 0xffff0000u); f[2] = __uint_as_float(u.y << 16); f[3] = __uint_as_float(u.y & 0xffff0000u);
    f[4] = __uint_as_float(u.z << 16); f[5] = __uint_as_float(u.z & 0xffff0000u); f[6] = __uint_as_float(u.w << 16); f[7] = __uint_as_float(u.w & 0xffff0000u); }
DEV v4u pack8(const float (&f)[8]) { v4u u; u.x = pk2(f[0], f[1]); u.y = pk2(f[2], f[3]); u.z = pk2(f[4], f[5]); u.w = pk2(f[6], f[7]); return u; }

struct TrJob { const float* src; int ldsrc, K, N; bf16_t* dst; int lddst, row_off, k_off, mode; float q8; };
DEV void tr_item(const TrJob& j, LAS float* scr, int item, int lane) {
    const int nblk = j.N / 32, kb = item / nblk, nb = item % nblk, k0 = 64 * kb, n0 = 32 * nb;
#pragma unroll 8
    for (int i = 0; i < 32; ++i) { const int kk = 2 * i + (lane >> 5); scr[kk * 33 + (lane & 31)] = j.src[(size_t)(k0 + kk) * j.ldsrc + n0 + (lane & 31)]; }
    LDS_WAIT(); asm volatile("" ::: "memory");
    const int c = lane & 7;
    const int rbase = j.row_off + (j.mode ? (((n0 >> 7) << 8) + (n0 & 127)) : n0);
#pragma unroll
    for (int jj = 0; jj < 4; ++jj) { const int n = (lane >> 3) + 8 * jj; const LAS float* s = scr + (8 * c) * 33 + n;
        if (j.q8 != 0.f) { const float q = j.q8; uint2 o; o.x = pk4_fp8(s[0 * 33] * q, s[1 * 33] * q, s[2 * 33] * q, s[3 * 33] * q); o.y = pk4_fp8(s[4 * 33] * q, s[5 * 33] * q, s[6 * 33] * q, s[7 * 33] * q);
            *(uint2*)((unsigned char*)j.dst + (size_t)(rbase + n) * j.lddst + j.k_off + k0 + 8 * c) = o; continue; }
        v4u o; o.x = pk2(s[0 * 33], s[1 * 33]); o.y = pk2(s[2 * 33], s[3 * 33]); o.z = pk2(s[4 * 33], s[5 * 33]); o.w = pk2(s[6 * 33], s[7 * 33]);
        *(v4u*)(j.dst + (size_t)(rbase + n) * j.lddst + j.k_off + k0 + 8 * c) = o; }
    LDS_WAIT(); asm volatile("" ::: "memory");
}
DEV void tr_run(Frame& F, const TrJob& j, int& base, int& nxt) {
    const int items = (j.K / 64) * (j.N / 32); LAS float* scr = (LAS float*)(F.lds + F.wave * 16384);
    while (nxt < base + items) { tr_item(j, scr, nxt - base, F.lane); nxt += F.NGW; }
    base += items;
}
DEV void p_prep_small_weights(Frame& F, CArgs A) {
    int base = 0, nxt = F.gw;
#pragma unroll
    for (int l = 0; l < 2; ++l) {
        const float* wl = A->in[2] + (size_t)l * D * NIN; bf16_t* WinT = (bf16_t*)(F.ws + WS_WIN) + (size_t)l * 8192 * 1024;
        { TrJob j{wl, NIN, D, 2560, WinT, D, 0, 0, 0, 0.f}; tr_run(F, j, base, nxt); }
        { TrJob j{wl + 2576, NIN, D, 2048, WinT, D, 2560, 0, 0, 0.f}; tr_run(F, j, base, nxt); }
        { TrJob j{wl + 4632, NIN, D, 3584, WinT, D, 4608, 0, 0, 0.f}; tr_run(F, j, base, nxt); }
        bf16_t* WupT = (bf16_t*)(F.ws + WS_WUP) + (size_t)l * 3072 * 512;
#pragma unroll
        for (int br = 0; br < 3; ++br) { TrJob j{A->in[9 + br] + (size_t)l * 512 * 1024, 1024, 512, 1024, WupT, 512, br * 1024, 0, 0, 0.f}; tr_run(F, j, base, nxt); }
        { TrJob j{A->in[12] + (size_t)l * D * D, D, D, D, (bf16_t*)(F.ws + WS_WO3) + (size_t)l * 1024 * 1024, D, 0, 0, 0, 0.f}; tr_run(F, j, base, nxt); }
    }
    { TrJob j{A->in[14], DFF, D, DFF, (bf16_t*)(F.ws + WS_WFGU), D, 0, 0, 1, 0.f}; tr_run(F, j, base, nxt); }
    { TrJob j{A->in[15], DFF, D, DFF, (bf16_t*)(F.ws + WS_WFGU), D, 128, 0, 1, 0.f}; tr_run(F, j, base, nxt); }
    { TrJob j{A->in[16], D, DFF, D, (bf16_t*)(F.ws + WS_WFD), DFF, 0, 0, 0, 0.f}; tr_run(F, j, base, nxt); }
}
DEV void p_sample_moe_amax(Frame& F, CArgs A) {
#pragma unroll
    for (int t = 0; t < 3; ++t) { const f32x4* src = (const f32x4*)A->in[19 + t]; float m = 0.f;
#pragma unroll
        for (int i = 0; i < 2; ++i) { const f32x4 v = src[(size_t)(F.gw * 2 + i) * ((size_t)8 * D * DFF / 4 / (2 * F.NGW)) + F.lane]; m = fmaxf(m, fmaxf(fmaxf(fabsf(v[0]), fabsf(v[1])), fmaxf(fabsf(v[2]), fabsf(v[3])))); }
        m = wave_max(m); if (F.lane == 0) __hip_atomic_fetch_max((unsigned*)(F.ws + WS_CTL) + CW_WAMAX + 64 * t, __float_as_uint(m), __ATOMIC_RELAXED, __HIP_MEMORY_SCOPE_AGENT); }
}
DEV void p_prep_moe_weights(Frame& F, CArgs A) {
    int base = 0, nxt = F.gw; const float* wam = (const float*)(F.ws + WS_CTL) + CW_WAMAX; const float qg = pow2_scale(wam[0]), qu = pow2_scale(wam[64]), qd = pow2_scale(wam[128]);
#pragma unroll 1
    for (int e = 0; e < 8; ++e) {
        unsigned char* GU8 = F.ws + WS_MGU + (size_t)e * 5632 * 1024; unsigned char* DW8 = F.ws + WS_MD + (size_t)e * 1024 * DFF;
        { TrJob j{A->in[19] + (size_t)e * D * DFF, DFF, D, DFF, (bf16_t*)GU8, D, 0, 0, 1, qg}; tr_run(F, j, base, nxt); }
        { TrJob j{A->in[20] + (size_t)e * D * DFF, DFF, D, DFF, (bf16_t*)GU8, D, 128, 0, 1, qu}; tr_run(F, j, base, nxt); }
        { TrJob j{A->in[21] + (size_t)e * D * DFF, D, DFF, D, (bf16_t*)DW8, DFF, 0, 0, 0, qd}; tr_run(F, j, base, nxt); }
    }
}
DEV void p_rope_table(Frame& F) {
    float* cs = (float*)(F.ws + WS_ROPE_COS); float* sn = (float*)(F.ws + WS_ROPE_SIN);
    for (int idx = F.vcu * NTHREADS + F.tid; idx < SEQ * 8; idx += F.G * NTHREADS) {
        const int s = idx >> 3, i = idx & 7; const float inv = (float)pow(500000.0, -(double)i / 8.0); const float ang = (float)s * inv;
        cs[idx] = (float)cos((double)ang); sn[idx] = (float)sin((double)ang); }
}

template <int NS, bool XBF = false, bool Q8 = false>
DEV void p_norm(Frame& F, const float* X, const float* g, bf16_t* XN, const float* W, int ldw, int c0a, int c0b, const float* bias, float* ZS, int* tope, float* topg) {
    LAS float* Wl = (LAS float*)F.lds; LAS unsigned* lcnt = (LAS unsigned*)(F.lds + 32768); LAS unsigned* lbase = lcnt + 8; LAS unsigned* stash = lcnt + 64 + F.wave * 32;
    if (NS == 8 && F.tid < 8) lcnt[F.tid] = 0u;
    int it_ = 0;
    if (NS > 0) {
        f32x4 wv[2][6];
#pragma unroll
        for (int p = 0; p < 2; ++p) { const float* wr = W + (size_t)(F.tid + 512 * p) * ldw;
#pragma unroll
            for (int q = 0; q < NS / 4; ++q) wv[p][q] = *(const f32x4*)(wr + ((NS == 24 && q >= 4) ? c0b + 4 * (q - 4) : c0a + 4 * q)); }
#pragma unroll
        for (int p = 0; p < 2; ++p)
#pragma unroll
            for (int q = 0; q < NS / 4; ++q)
#pragma unroll
                for (int i = 0; i < 4; ++i) { if (NS == 24) *(LAS bf16_t*)(F.lds + (4 * q + i) * 2064 + (F.tid + 512 * p) * 2) = f2bf(wv[p][q][i]); else Wl[(4 * q + i) * D + F.tid + 512 * p] = wv[p][q][i]; }
        if (NS == 24) { for (int idx = F.tid; idx < 8 * 1024; idx += NTHREADS) *(LAS bf16_t*)(F.lds + (24 + (idx >> 10)) * 2064 + (idx & 1023) * 2) = 0; }
        __syncthreads();
    }
    f32x4 gg[4];
#pragma unroll
    for (int j = 0; j < 4; ++j) gg[j] = ((const f32x4*)g + F.lane)[64 * j];
    for (int mb = F.gw; mb < T; mb += 4 * F.NGW) {
      f32x4 vv[4][4];
#pragma unroll
      for (int u = 0; u < 4; ++u) { const int mu = mb + u * F.NGW; if (mu < T) {
          if (XBF) { const uint2* xr = (const uint2*)((const bf16_t*)X + (size_t)mu * D) + F.lane;
#pragma unroll
              for (int j = 0; j < 4; ++j) { const uint2 w = xr[64 * j]; vv[u][j] = (f32x4){__uint_as_float(w.x << 16), __uint_as_float(w.x & 0xffff0000u), __uint_as_float(w.y << 16), __uint_as_float(w.y & 0xffff0000u)}; } }
          else { const f32x4* xr = (const f32x4*)(X + (size_t)mu * D) + F.lane;
#pragma unroll
              for (int j = 0; j < 4; ++j) vv[u][j] = xr[64 * j]; } } }
#pragma unroll
      for (int u = 0; u < 4; ++u) { const int m = mb + u * F.NGW; if (m >= T) break;
        f32x4 v[4]; float ss = 0.f;
#pragma unroll
        for (int j = 0; j < 4; ++j) { v[j] = vv[u][j]; ss += v[j][0] * v[j][0] + v[j][1] * v[j][1] + v[j][2] * v[j][2] + v[j][3] * v[j][3]; }
        const float rstd = rsqrtf(wave_sum(ss) * (1.f / D) + EPS);
#pragma unroll
        for (int j = 0; j < 4; ++j) v[j] = v[j] * rstd * gg[j];
        if (Q8) {
            float am = 0.f;
#pragma unroll
            for (int j = 0; j < 4; ++j) am = fmaxf(am, fmaxf(fmaxf(fabsf(v[j][0]), fabsf(v[j][1])), fmaxf(fabsf(v[j][2]), fabsf(v[j][3]))));
            am = fmaxf(wave_max(am), 1e-30f); const float q = 240.f / am; unsigned* o8 = (unsigned*)((unsigned char*)XN + (size_t)m * D) + F.lane;
#pragma unroll
            for (int j = 0; j < 4; ++j) o8[64 * j] = pk4_fp8(v[j][0] * q, v[j][1] * q, v[j][2] * q, v[j][3] * q);
            if (F.lane == 0) ((float*)(F.ws + WS_RS))[m] = am * (1.f / 240.f);
        } else {
        uint2* o = (uint2*)(XN + (size_t)m * D) + F.lane;
#pragma unroll
        for (int j = 0; j < 4; ++j) { uint2 w; w.x = pk2(v[j][0], v[j][1]); w.y = pk2(v[j][2], v[j][3]); o[64 * j] = w; }
        }
        if (NS == 8) {
            float lg[8];
#pragma unroll
            for (int c = 0; c < 8; ++c) { const LAS f32x4* wr = (const LAS f32x4*)(Wl + c * D) + F.lane; float a = 0.f;
#pragma unroll
                for (int j = 0; j < 4; ++j) { const f32x4 w = wr[64 * j]; a += v[j][0] * w[0] + v[j][1] * w[1] + v[j][2] * w[2] + v[j][3] * w[3]; }
                lg[c] = wave_sum(a) + bias[c]; }
            int e1 = 0; float l1 = lg[0];
#pragma unroll
            for (int c = 1; c < 8; ++c) if (lg[c] > l1) { l1 = lg[c]; e1 = c; }
            int e2 = -1; float l2 = -INFINITY;
#pragma unroll
            for (int c = 0; c < 8; ++c) if (c != e1 && lg[c] > l2) { l2 = lg[c]; e2 = c; }
            if (F.lane == 0) { const float g2 = 1.f / (1.f + __expf(l1 - l2)); tope[m * 2] = e1; tope[m * 2 + 1] = e2; topg[m * 2] = 1.f - g2; topg[m * 2 + 1] = g2;
                stash[(it_ & 15) * 2] = ((unsigned)e1 << 16) | __hip_atomic_fetch_add(lcnt + e1, 1u, __ATOMIC_RELAXED, __HIP_MEMORY_SCOPE_WORKGROUP);
                stash[(it_ & 15) * 2 + 1] = ((unsigned)e2 << 16) | __hip_atomic_fetch_add(lcnt + e2, 1u, __ATOMIC_RELAXED, __HIP_MEMORY_SCOPE_WORKGROUP); }
            ++it_;
        }
      }
    }
    if (NS > 0) __syncthreads();
    if (NS == 24) {
        const int ti = F.wave >> 2, kq = F.wave & 3, r = F.lane & 31, hh = F.lane >> 5; const int rows_per = (T + F.NGW - 1) / F.NGW;
        const int it_r = 4 * ti + (r >> 3); int mrow = F.vcu * NWAVES + (r & 7) + F.NGW * it_r; const bool rok = it_r < rows_per && mrow < T; if (!rok) mrow = 0;
        const bf16_t* arow = XN + (size_t)mrow * D + kq * 256 + 8 * hh; const LAS unsigned char* brow = F.lds + r * 2064 + (kq * 256 + 8 * hh) * 2; f32x16 acc = {};
        bf16x8 af[16];
#pragma unroll
        for (int k = 0; k < 16; ++k) af[k] = *(const bf16x8*)(arow + 16 * k);
#pragma unroll
        for (int k = 0; k < 16; ++k) acc = MFMA32(af[k], *(const LAS bf16x8*)(brow + 32 * k), acc);
        LAS float* PART = (LAS float*)(F.lds + 69632) + F.wave * 1024;
#pragma unroll
        for (int g = 0; g < 16; ++g) PART[crow(g, hh) * 32 + r] = acc[g];
        __syncthreads();
        { const int t2 = F.tid >> 8, idx = F.tid & 255, rr = idx >> 3, cg = idx & 7; const LAS float* P0 = (const LAS float*)(F.lds + 69632) + t2 * 4096 + rr * 32 + cg * 4;
          const f32x4 sum = *(const LAS f32x4*)P0 + *(const LAS f32x4*)(P0 + 1024) + *(const LAS f32x4*)(P0 + 2048) + *(const LAS f32x4*)(P0 + 3072);
          const int it2 = 4 * t2 + (rr >> 3), m2 = F.vcu * NWAVES + (rr & 7) + F.NGW * it2;
          if (cg < 6 && it2 < rows_per && m2 < T) { const int cb_ = (cg < 4) ? c0a + 4 * cg : c0b + 4 * (cg - 4); *(f32x4*)(ZS + (size_t)m2 * 24 + 4 * cg) = sum + *(const f32x4*)(bias + cb_); } }
        __syncthreads();
    }
    if (NS == 8) {
        if (F.tid < 8) lbase[F.tid] = __hip_atomic_fetch_add((unsigned*)(F.ws + WS_CTL) + CW_MOECNT + 64 * F.tid, lcnt[F.tid], __ATOMIC_RELAXED, __HIP_MEMORY_SCOPE_AGENT);
        __syncthreads();
        int* POS = (int*)(F.ws + WS_SLOT); int i2 = 0;
        for (int m = F.gw; m < T; m += F.NGW) { if (F.lane < 2) { const unsigned st = stash[(i2 & 15) * 2 + F.lane]; POS[m * 2 + F.lane] = (int)(lbase[st >> 16] + (st & 0xffffu)); } ++i2; }
        __syncthreads();
    }
}

DEV void p_mixer_prep(Frame& F, CArgs A, int l) {
    bf16_t* ZA = (bf16_t*)(F.ws + WS_ZA); const float* cs = (const float*)(F.ws + WS_ROPE_COS); const float* sn = (const float*)(F.ws + WS_ROPE_SIN);
    const int gt = F.vcu * NTHREADS + F.tid, NT = F.G * NTHREADS;
    float* KM = (float*)(F.ws + WS_KM); LAS float* red = (LAS float*)F.lds;
    for (int it = F.vcu; it < 512; it += F.G) { const int j = it & 31, h = (it >> 5) & 7, b = it >> 8, s0 = j * 256 + 32 * F.wave;
        bf16_t* base = ZA + (size_t)(b * SEQ + s0) * ZA_LD + ZA_MK + h * 64 + F.lane; float vals[32]; float acc = 0.f;
#pragma unroll
        for (int r = 0; r < 32; ++r) vals[r] = bf2f(base[(size_t)r * ZA_LD]);
        float cc[32], sc[32];
#pragma unroll
        for (int r = 0; r < 32; ++r) { cc[r] = cs[(s0 + r) * 8 + (F.lane & 7)]; sc[r] = sn[(s0 + r) * 8 + (F.lane & 7)]; }
#pragma unroll
        for (int r = 0; r < 32; ++r) { float val = vals[r]; const float oth = __shfl_xor(val, 8);
            if (F.lane < 16) { const float c = cc[r], sv = sc[r]; const float nv = (F.lane < 8) ? (val * c - oth * sv) : (val * c + oth * sv);
                const bf16_t nb = f2bf(nv); base[(size_t)r * ZA_LD] = nb; val = bf2f(nb); }
            acc += val; }
        red[F.wave * 64 + F.lane] = acc; __syncthreads();
        if (F.wave == 0) { float t = 0.f;
#pragma unroll
            for (int w = 0; w < 8; ++w) t += red[w * 64 + F.lane];
            KM[(size_t)it * 64 + F.lane] = t * (1.f / 256.f); }
        __syncthreads(); }
}

DEV void p_route_gather(Frame& F) {
    const unsigned* gcnt = (const unsigned*)(F.ws + WS_CTL) + CW_MOECNT; const int* tope = (const int*)(F.ws + WS_TOPE); int* slot = (int*)(F.ws + WS_SLOT);
    int cnt[8], pst[8], pad0[8]; int run = 0, prun = 0;
#pragma unroll
    for (int e = 0; e < 8; ++e) { cnt[e] = (int)__builtin_amdgcn_readfirstlane(gcnt[64 * e]); pst[e] = run; pad0[e] = prun; const int padded = (cnt[e] + 255) & ~255; run += padded; prun += padded - cnt[e]; }
    if (F.vcu == 0 && F.tid == 0) { int* blk_e = (int*)(F.ws + WS_BLK_E); int nb = 0;
#pragma unroll
        for (int e = 0; e < 8; ++e) { const int nbe = (cnt[e] + 255) >> 8; for (int j = 0; j < nbe; ++j) blk_e[nb++] = e; }
        *(int*)(F.ws + WS_NBLK) = nb;
        int* TQ = (int*)(F.ws + WS_ROWS_TOK); const int units = nb * 4, R = units / F.G, Lc = units - R * F.G; const int ns = 0;
        for (int t = 0; t < units; ++t) TQ[t] = -1;
        for (int q = 0; q < ns; ++q) { int pm, pn; unit_tile(R * F.G + q, nb, 4, pm, pn); TQ[pm * 4 + pn] = q; }
        TQ[1024] = ns; TQ[1025] = R; }
    const unsigned char* XQ = F.ws + WS_XN2; unsigned char* XG8 = F.ws + WS_YM; const float* RS = (const float*)(F.ws + WS_RS); float* RSG = (float*)(F.ws + WS_RSG);
    for (int mb = F.gw; mb < T; mb += 4 * F.NGW) { v4u ra[4]; float rsv[4]; int ee[4][2], pp[4][2];
#pragma unroll
        for (int u = 0; u < 4; ++u) { const int m = mb + u * F.NGW < T ? mb + u * F.NGW : mb; ra[u] = ((const v4u*)(XQ + (size_t)m * D))[F.lane]; rsv[u] = RS[m];
            ee[u][0] = tope[m * 2]; ee[u][1] = tope[m * 2 + 1]; pp[u][0] = slot[m * 2]; pp[u][1] = slot[m * 2 + 1]; }
#pragma unroll
        for (int u = 0; u < 4; ++u) { const int m = mb + u * F.NGW; if (m >= T) break;
#pragma unroll
            for (int k = 0; k < 2; ++k) { const int e = ee[u][k]; int ps = 0;
#pragma unroll
                for (int q = 0; q < 8; ++q) ps = (e == q) ? pst[q] : ps;
                const int dest = ps + pp[u][k]; ((v4u*)(XG8 + (size_t)dest * D))[F.lane] = ra[u];
                if (F.lane == 0) { slot[m * 2 + k] = dest; RSG[dest] = rsv[u]; } } } }
    for (int r = F.gw; r < prun; r += F.NGW) { int row = 0;
#pragma unroll
        for (int e = 0; e < 8; ++e) { if (r >= pad0[e]) row = pst[e] + cnt[e] + (r - pad0[e]); }
        const v4u z = {0u, 0u, 0u, 0u}; ((v4u*)(XG8 + (size_t)row * D))[F.lane] = z; if (F.lane == 0) RSG[row] = 0.f; }
}
DEV void p_combine_final(Frame& F, CArgs A) {
    float* X = F.X; const bf16_t* YM = (const bf16_t*)(F.ws + WS_YM); const int* slot = (const int*)(F.ws + WS_SLOT); const float* topg = (const float*)(F.ws + WS_TOPG); const f32x4* gr = (const f32x4*)A->in[22] + F.lane;
    f32x4 gg[4];
#pragma unroll
    for (int j = 0; j < 4; ++j) gg[j] = gr[64 * j];
    const int* TQ = (const int*)(F.ws + WS_ROWS_TOK); const bf16_t* YB = (const bf16_t*)(F.ws + WS_XN2); const int nsplit_ = TQ[1024];
    for (int mb = F.gw; mb < T; mb += 4 * F.NGW) {
        int s0[4], s1[4]; float g0[4], g1[4]; f32x4 xv[4][4]; uint2 ya[4][4], yb[4][4];
#pragma unroll
        for (int u = 0; u < 4; ++u) { const int m = mb + u * F.NGW < T ? mb + u * F.NGW : mb; s0[u] = slot[m * 2]; s1[u] = slot[m * 2 + 1]; g0[u] = topg[m * 2]; g1[u] = topg[m * 2 + 1];
            const f32x4* xr = (const f32x4*)(X + (size_t)m * D) + F.lane;
#pragma unroll
            for (int j = 0; j < 4; ++j) xv[u][j] = xr[64 * j]; }
#pragma unroll
        for (int u = 0; u < 4; ++u) { const uint2* y0 = (const uint2*)(YM + (size_t)s0[u] * D) + F.lane; const uint2* y1 = (const uint2*)(YM + (size_t)s1[u] * D) + F.lane;
#pragma unroll
            for (int j = 0; j < 4; ++j) { ya[u][j] = y0[64 * j]; yb[u][j] = y1[64 * j]; } }
        if (nsplit_ > 0) {
#pragma unroll
            for (int u = 0; u < 4; ++u)
#pragma unroll
                for (int j = 0; j < 4; ++j) { const int q0 = TQ[(s0[u] >> 8) * 4 + j], q1 = TQ[(s1[u] >> 8) * 4 + j];
                    if (q0 >= 0) { const uint2 e = *((const uint2*)(YB + (size_t)q0 * 65536 + (s0[u] & 255) * 256) + F.lane); xv[u][j] += g0[u] * (f32x4){__uint_as_float(e.x << 16), __uint_as_float(e.x & 0xffff0000u), __uint_as_float(e.y << 16), __uint_as_float(e.y & 0xffff0000u)}; }
                    if (q1 >= 0) { const uint2 e = *((const uint2*)(YB + (size_t)q1 * 65536 + (s1[u] & 255) * 256) + F.lane); xv[u][j] += g1[u] * (f32x4){__uint_as_float(e.x << 16), __uint_as_float(e.x & 0xffff0000u), __uint_as_float(e.y << 16), __uint_as_float(e.y & 0xffff0000u)}; } } }
#pragma unroll
        for (int u = 0; u < 4; ++u) { const int m = mb + u * F.NGW; if (m >= T) break;
            f32x4 v[4]; float ss = 0.f;
#pragma unroll
            for (int j = 0; j < 4; ++j) { v[j] = xv[u][j]; const uint2 a = ya[u][j], c = yb[u][j];
                v[j][0] += g0[u] * __uint_as_float(a.x << 16) + g1[u] * __uint_as_float(c.x << 16); v[j][1] += g0[u] * __uint_as_float(a.x & 0xffff0000u) + g1[u] * __uint_as_float(c.x & 0xffff0000u);
                v[j][2] += g0[u] * __uint_as_float(a.y << 16) + g1[u] * __uint_as_float(c.y << 16); v[j][3] += g0[u] * __uint_as_float(a.y & 0xffff0000u) + g1[u] * __uint_as_float(c.y & 0xffff0000u);
                ss += v[j][0] * v[j][0] + v[j][1] * v[j][1] + v[j][2] * v[j][2] + v[j][3] * v[j][3]; }
            const float rstd = rsqrtf(wave_sum(ss) * (1.f / D) + EPS); f32x4* xo = (f32x4*)(X + (size_t)m * D) + F.lane;
#pragma unroll
            for (int j = 0; j < 4; ++j) xo[64 * j] = v[j] * rstd * gg[j]; }
    }
}

namespace attn_body {
using bf16=__hip_bfloat16;
using bf16x8=__attribute__((ext_vector_type(8)))short;
using s16x4=__attribute__((ext_vector_type(4)))short;
using f32x16=__attribute__((ext_vector_type(16)))float;
using u32x4=__attribute__((ext_vector_type(4)))unsigned;
constexpr int BATCH=2,NHEAD=8,SEQ=8192,D=64,PQ=5120,PO=512;
constexpr int NW=8,QBLK=32,QB=QBLK*NW,KVBLK=64,NQB=SEQ/QB;
constexpr int ATTN_UNIT_ROWS=QB;
__device__ __forceinline__ int crow(int r,int hi){return (r&3)+8*(r>>2)+4*hi;}
#define SBAR() __builtin_amdgcn_sched_barrier(0)
__device__ __forceinline__ void cmask(f32x16&p0,f32x16&p1,int jb,int qrel,int hi){
  const float NEG=-INFINITY; int kb=64*jb+4*hi;
  #pragma unroll
  for(int r=0;r<16;++r){int kv=kb+(r&3)+8*(r>>2); if(kv>qrel)p0[r]=NEG; if(kv+32>qrel)p1[r]=NEG;}
}

constexpr int NSLOT=3, SLOTB=8192;
constexpr int LDS_K=0, LDS_V=NSLOT*SLOTB, LDS_WS=2*NSLOT*SLOTB, LDS_OST=LDS_WS+NW*64*4, LDS_BYTES=LDS_OST+NW*4096;
constexpr float C2=0.125f*1.4426950408889634f;
__device__ __forceinline__ void glds16(const void*gsrc,unsigned lds_dst){unsigned keep;
  asm volatile("s_mov_b32 %0, m0\n\ts_mov_b32 m0, %2\n\ts_nop 0\n\tglobal_load_lds_dwordx4 %1, off\n\ts_mov_b32 m0, %0":"=&s"(keep):"v"(gsrc),"s"(lds_dst):"memory");}
__device__ __forceinline__ float max3f(float a,float b,float c){float r;asm("v_max3_f32 %0, %1, %2, %3":"=v"(r):"v"(a),"v"(b),"v"(c));return r;}
__device__ __forceinline__ float max2f(float a,float b){float r;asm("v_max_f32_e32 %0, %1, %2":"=v"(r):"v"(a),"v"(b));return r;}
__device__ __forceinline__ float fadd_s(float a,float b){float r;asm("v_add_f32_e32 %0, %1, %2":"=v"(r):"v"(a),"v"(b));return r;}
__device__ __forceinline__ float fsub_s(float a,float b){float r;asm("v_sub_f32_e32 %0, %1, %2":"=v"(r):"v"(a),"v"(b));return r;}
typedef float f32x2_t __attribute__((ext_vector_type(2))); typedef __bf16 bf16x2_t __attribute__((ext_vector_type(2)));
__device__ __forceinline__ unsigned cvtpk_s(float lo,float hi){f32x2_t v={lo,hi};bf16x2_t b=__builtin_convertvector(v,bf16x2_t);return __builtin_bit_cast(unsigned,b);}
#define WAIT_BAR(N) asm volatile("s_waitcnt vmcnt(" #N ") lgkmcnt(0)\n\ts_barrier":::"memory")

__device__ __forceinline__ void qkt(f32x16&p0,f32x16&p1,const char*Kslot,const bf16x8*qr,const f32x16&negm,int r32,int hi){
  const char*kb=Kslot+hi*1024+r32*16;
  #pragma unroll
  for(int d0=0;d0<4;++d0){
    const bf16x8 b0=*reinterpret_cast<const bf16x8*>(kb+d0*2048);
    const bf16x8 b1=*reinterpret_cast<const bf16x8*>(kb+d0*2048+512);
    if(d0==0){p0=__builtin_amdgcn_mfma_f32_32x32x16_bf16(b0,qr[0],negm,0,0,0);p1=__builtin_amdgcn_mfma_f32_32x32x16_bf16(b1,qr[0],negm,0,0,0);}
    else{p0=__builtin_amdgcn_mfma_f32_32x32x16_bf16(b0,qr[d0],p0,0,0,0);p1=__builtin_amdgcn_mfma_f32_32x32x16_bf16(b1,qr[d0],p1,0,0,0);}}
}
typedef __attribute__((address_space(3))) const char* lds_cptr;
typedef short v4i16_t __attribute__((ext_vector_type(4)));
__device__ __forceinline__ void kload8(bf16x8*kf,lds_cptr kp){
  kf[0]=*(const __attribute__((address_space(3))) bf16x8*)(kp);      kf[1]=*(const __attribute__((address_space(3))) bf16x8*)(kp+512);
  kf[2]=*(const __attribute__((address_space(3))) bf16x8*)(kp+2048); kf[3]=*(const __attribute__((address_space(3))) bf16x8*)(kp+2560);
  kf[4]=*(const __attribute__((address_space(3))) bf16x8*)(kp+4096); kf[5]=*(const __attribute__((address_space(3))) bf16x8*)(kp+4608);
  kf[6]=*(const __attribute__((address_space(3))) bf16x8*)(kp+6144); kf[7]=*(const __attribute__((address_space(3))) bf16x8*)(kp+6656);
}
__device__ __forceinline__ void kload2(bf16x8*kf,lds_cptr kp,int j){ kf[2*j]=*(const __attribute__((address_space(3))) bf16x8*)(kp+j*2048); kf[2*j+1]=*(const __attribute__((address_space(3))) bf16x8*)(kp+j*2048+512); }
__device__ __forceinline__ s16x4 vtr(lds_cptr p){ return __builtin_bit_cast(s16x4,__builtin_amdgcn_ds_read_tr16_b64_v4i16((__attribute__((address_space(3))) v4i16_t*)p)); }
__device__ __forceinline__ float rowmax(const f32x16&p0,const f32x16&p1){
  float a=max3f(p0[0],p0[1],p1[0]),b=max3f(p0[2],p0[3],p1[1]);a=max3f(a,p1[2],p1[3]);
  #pragma unroll
  for(int r=4;r<16;r+=4){a=max3f(a,p0[r],p0[r+1]);b=max3f(b,p0[r+2],p0[r+3]);a=max3f(a,p1[r],p1[r+1]);b=max3f(b,p1[r+2],p1[r+3]);}
  const float m=max2f(a,b);
  auto rr=__builtin_amdgcn_permlane32_swap(__float_as_uint(m),__float_as_uint(m),false,false);
  return max2f(__uint_as_float(rr[0]),__uint_as_float(rr[1]));
}
__device__ __forceinline__ void pv(f32x16*o,int vb,bf16x8 pa0,bf16x8 pa1,bf16x8 pa2,bf16x8 pa3){
  #pragma unroll
  for(int d0=0;d0<2;++d0){s16x4 lo[4],hi[4];
    #pragma unroll
    for(int ks=0;ks<4;++ks){
      asm volatile("ds_read_b64_tr_b16 %0,%1 offset:%c2":"=&v"(lo[ks]):"v"(vb),"i"(d0*4096+ks*1024):"memory");
      asm volatile("ds_read_b64_tr_b16 %0,%1 offset:%c2":"=&v"(hi[ks]):"v"(vb),"i"(d0*4096+ks*1024+512):"memory");}
    asm volatile("s_waitcnt lgkmcnt(0)":::"memory");SBAR();
    #define PK(k) (bf16x8){lo[k][0],lo[k][1],lo[k][2],lo[k][3],hi[k][0],hi[k][1],hi[k][2],hi[k][3]}
    o[d0]=__builtin_amdgcn_mfma_f32_32x32x16_bf16(pa0,PK(0),o[d0],0,0,0);
    o[d0]=__builtin_amdgcn_mfma_f32_32x32x16_bf16(pa1,PK(1),o[d0],0,0,0);
    o[d0]=__builtin_amdgcn_mfma_f32_32x32x16_bf16(pa2,PK(2),o[d0],0,0,0);
    o[d0]=__builtin_amdgcn_mfma_f32_32x32x16_bf16(pa3,PK(3),o[d0],0,0,0);
    #undef PK
  }
}

#ifndef ATTN_STORE16
#define ATTN_STORE16(p,v) (*(u32x4*)(p)=(v))
#endif
template<int THRL,bool CAUSAL> __device__ __forceinline__ void attn_unit(int tid,int b,int h,int jb,const unsigned short*list,int g,int cnt,const bf16*Q,const bf16*__restrict__ K,const bf16*__restrict__ V,bf16*PO,float*ML,const float*rcs,const float*rsn,char*shm){
  const int lane=tid&63,r32=lane&31,hi=lane>>5; const int wid=__builtin_amdgcn_readfirstlane(tid>>6);
  const long rowbase=(long)b*SEQ;
  int s_,rank_; bool valid_;
  if(CAUSAL){ s_=jb*QB+wid*QBLK+r32; rank_=3; valid_=true; }
  else{ const int li=g*QB+wid*QBLK+r32; valid_=li<cnt; const unsigned e_=list[valid_?li:0]; s_=(int)(e_&0x1fffu); rank_=(int)(e_>>13); }
  const bf16*Qrow=Q+(rowbase+s_)*PQ+h*D;
  const bf16*Kh=K+(rowbase+(long)jb*QB)*PQ+h*D,*Vh=V+(rowbase+(long)jb*QB)*PQ+h*D;
  const unsigned lds0=(unsigned)(uintptr_t)shm;
  float*wsf=(float*)(shm+LDS_WS)+wid*64;
  const bf16*ksrc=Kh+(long)lane*PQ+wid*8;
  const bf16*vsrc=Vh+(long)(16*(wid&3)+(lane>>2))*PQ+(wid>>2)*32+(lane&3)*8;
  const unsigned kdst=lds0+LDS_K+wid*1024, vdst=lds0+LDS_V+wid*1024;
  #define TSRC(u) (u)
  #define DMA_K(t,slot) glds16(ksrc+(long)TSRC(t)*KVBLK*PQ,(unsigned)__builtin_amdgcn_readfirstlane(kdst+(slot)))
  #define DMA_V(t,slot) glds16(vsrc+(long)TSRC(t)*KVBLK*PQ,(unsigned)__builtin_amdgcn_readfirstlane(vdst+(slot)))
  const int vb0=(int)(lds0+LDS_V)+((lane>>4)&1)*32+(lane&3)*8+(4*hi+((lane&15)>>2))*64;
  const char*Kbase=shm+LDS_K; bf16x8 kf[8];
  const lds_cptr shm3=(lds_cptr)shm; const lds_cptr kp0=shm3+LDS_K+hi*1024+r32*16; const lds_cptr vp0=shm3+LDS_V+((lane>>4)&1)*32+(lane&3)*8+(4*hi+((lane&15)>>2))*64;
  constexpr int NT=4;
  DMA_K(0,0);DMA_V(0,0);DMA_K(1,SLOTB);
  bf16x8 qr[4];
  #pragma unroll
  for(int d0=0;d0<4;++d0)qr[d0]=*reinterpret_cast<const bf16x8*>(&Qrow[d0*16+hi*8]);
  {
    typedef float f4_t __attribute__((ext_vector_type(4))); const f4_t c0=*reinterpret_cast<const f4_t*>(rcs+s_*8),c1=*reinterpret_cast<const f4_t*>(rcs+s_*8+4),n0=*reinterpret_cast<const f4_t*>(rsn+s_*8),n1=*reinterpret_cast<const f4_t*>(rsn+s_*8+4);
    const float cc_[8]={c0[0],c0[1],c0[2],c0[3],c1[0],c1[1],c1[2],c1[3]}, ss_[8]={n0[0],n0[1],n0[2],n0[3],n1[0],n1[1],n1[2],n1[3]};
    #pragma unroll
    for(int d0=0;d0<4;++d0){ float f_[8];
      #pragma unroll
      for(int i=0;i<8;++i)f_[i]=__uint_as_float(((unsigned)(unsigned short)qr[d0][i])<<16);
      if(d0==0){
        #pragma unroll
        for(int i=0;i<8;++i){ const float oth=__shfl_xor(f_[i],32); f_[i]=hi?(f_[i]*cc_[i]+oth*ss_[i]):(f_[i]*cc_[i]-oth*ss_[i]); } }
      #pragma unroll
      for(int i=0;i<8;i+=2){ const unsigned w_=cvtpk_s(f_[i]*C2,f_[i+1]*C2); qr[d0][i]=(short)(w_&0xffffu); qr[d0][i+1]=(short)(w_>>16); } } }
  float mhat=0.f,l_reg=0.f;f32x16 o[2];o[0]=f32x16{};o[1]=f32x16{};const f32x16 Z16=f32x16{};
  #define CMASK(P0,P1,t) do{ if((t)>0){ _Pragma("unroll") for(int r_=0;r_<16;++r_){P0[r_]-=mhat;P1[r_]-=mhat;} } \
    if(CAUSAL){ unsigned ln_; asm volatile("v_mbcnt_lo_u32_b32 %0, -1, 0\n\tv_mbcnt_hi_u32_b32 %0, -1, %0":"=v"(ln_)); cmask(P0,P1,(t),wid*QBLK+(int)(ln_&31u),(int)(ln_>>5)); } }while(0)
  bool resc=false;
  #define START(P0,P1) do{ const float rm=rowmax(P0,P1); resc=false; \
    { const float dl=rm; mhat=fadd_s(mhat,dl); \
      _Pragma("unroll") for(int r=0;r<16;++r){P0[r]=fsub_s(P0[r],dl);P1[r]=fsub_s(P1[r],dl);} \
      } \
    _Pragma("unroll") for(int r=0;r<16;++r)P0[r]=__builtin_amdgcn_exp2f(P0[r]); }while(0)
  #define RESC() do{ if(resc){ asm volatile("s_waitcnt lgkmcnt(0)":::"memory"); \
      _Pragma("unroll") for(int d_=0;d_<2;++d_) _Pragma("unroll") for(int r=0;r<16;++r)o[d_][r]*=wsf[crow(r,hi)]; } }while(0)
  f32x16 pA0,pA1,pB0,pB1;
  int sl_prev=0,sl_cur=0,sl_next=SLOTB;
  #define ROT() do{sl_prev=sl_cur;sl_cur=sl_next;sl_next=(sl_next==(NSLOT-1)*SLOTB)?0:sl_next+SLOTB;}while(0)
  DMA_K(2,2*SLOTB);
  WAIT_BAR(3);
  qkt(pA0,pA1,Kbase,qr,Z16,r32,hi);asm volatile("s_nop 15\n\ts_nop 7":"+v"(pA0),"+v"(pA1));CMASK(pA0,pA1,0);
  START(pA0,pA1);
  _Pragma("unroll") for(int r=0;r<16;++r)pA1[r]=__builtin_amdgcn_exp2f(pA1[r]);
  WAIT_BAR(0);
  DMA_K(3,0);DMA_V(1,SLOTB);
  ROT();
  kload8(kf,kp0+sl_cur);
  WAIT_BAR(2);
  s16x4 vlo[8],vhi[8]; u32x4 pw0,pw1,pw2,pw3;
  #define PKW(P,B) cvtpk_s(P[B],P[B+1])
  #define PAF(k) __builtin_bit_cast(bf16x8,pw##k)
  #define VFR(i) (bf16x8){vlo[i][0],vlo[i][1],vlo[i][2],vlo[i][3],vhi[i][0],vhi[i][1],vhi[i][2],vhi[i][3]}
  #define PIN(x) asm volatile("":"+v"(x))
  #define MX3(a,b,c) __builtin_fmaxf(__builtin_fmaxf((a),(b)),(c))
  #define GAPA(MF,A0,A1,A2,A3,W0,W1,PW) do{ MF; sacc+=A0; sacc+=A1; sacc+=A2; sacc+=A3; PIN(sacc); W0; W1; PIN(PW); SBAR(); }while(0)
  #define EX(v) __builtin_amdgcn_exp2f(v)
  #define GAPB(MF,X,B) do{ MF; X[B]=EX(X[B]); X[B+1]=EX(X[B+1]); X[B+2]=EX(X[B+2]); X[B+3]=EX(X[B+3]); PIN(X); SBAR(); }while(0)
  #define VRD(i) do{ vlo[i]=vtr(vp_+(((i)>>2)*4096+((i)&3)*1024)); vhi[i]=vtr(vp_+(((i)>>2)*4096+((i)&3)*1024+512)); }while(0)
  #define KRD(G,j) do{ if(G){ kload2(kf,kp0+sl_next,j); SBAR(); } }while(0)
  #define STEP(C0,C1,P0,P1,t,GK,GV,GL) do{ SBAR(); \
    const lds_cptr vp_=vp0+sl_prev; \
    VRD(0); SBAR(); float sacc=(P0[0]+P0[1]); \
    GAPA(C0=__builtin_amdgcn_mfma_f32_32x32x16_bf16(kf[0],qr[0],Z16,0,0,0), P0[2],P0[3],P0[4],P0[5],     pw0[0]=PKW(P0,0), pw0[1]=PKW(P0,2), pw0); \
    VRD(4); SBAR(); GAPA(C1=__builtin_amdgcn_mfma_f32_32x32x16_bf16(kf[1],qr[0],Z16,0,0,0), P0[6],P0[7],P0[8],P0[9],     pw0[2]=PKW(P0,4), pw0[3]=PKW(P0,6), pw0); \
    VRD(1); SBAR(); GAPA(C0=__builtin_amdgcn_mfma_f32_32x32x16_bf16(kf[2],qr[1],C0,0,0,0),   P0[10],P0[11],P0[12],P0[13], pw1[0]=PKW(P0,8), pw1[1]=PKW(P0,10), pw1); \
    VRD(5); SBAR(); GAPA(C1=__builtin_amdgcn_mfma_f32_32x32x16_bf16(kf[3],qr[1],C1,0,0,0),   P0[14],P0[15],P1[0],P1[1],   pw1[2]=PKW(P0,12),pw1[3]=PKW(P0,14), pw1); \
    VRD(2); SBAR(); GAPA(C0=__builtin_amdgcn_mfma_f32_32x32x16_bf16(kf[4],qr[2],C0,0,0,0),   P1[2],P1[3],P1[4],P1[5],     pw2[0]=PKW(P1,0), pw2[1]=PKW(P1,2), pw2); \
    VRD(6); SBAR(); GAPA(C1=__builtin_amdgcn_mfma_f32_32x32x16_bf16(kf[5],qr[2],C1,0,0,0),   P1[6],P1[7],P1[8],P1[9],     pw2[2]=PKW(P1,4), pw2[3]=PKW(P1,6), pw2); \
    VRD(3); SBAR(); GAPA(C0=__builtin_amdgcn_mfma_f32_32x32x16_bf16(kf[6],qr[3],C0,0,0,0),   P1[10],P1[11],P1[12],P1[13], pw3[0]=PKW(P1,8), pw3[1]=PKW(P1,10), pw3); \
    VRD(7); SBAR(); GAPA(C1=__builtin_amdgcn_mfma_f32_32x32x16_bf16(kf[7],qr[3],C1,0,0,0),   P1[14],P1[15],0.f,0.f,       pw3[2]=PKW(P1,12),pw3[3]=PKW(P1,14), pw3); \
    l_reg+=sacc; \
    if(GK){DMA_K((t)+3,sl_cur);} if(GV){DMA_V((t)+1,sl_next);} \
    CMASK(C0,C1,t); \
    { float a=MX3(C0[0],C0[1],C1[0]),b=MX3(C0[2],C0[3],C1[1]); a=MX3(a,C1[2],C1[3]); \
      _Pragma("unroll") for(int r=4;r<16;r+=4){a=MX3(a,C0[r],C0[r+1]);b=MX3(b,C0[r+2],C0[r+3]);a=MX3(a,C1[r],C1[r+1]);b=MX3(b,C1[r+2],C1[r+3]);} \
      float rm=__builtin_fmaxf(a,b); { auto rr=__builtin_amdgcn_permlane32_swap(__float_as_uint(rm),__float_as_uint(rm),false,false); rm=__builtin_fmaxf(__uint_as_float(rr[0]),__uint_as_float(rr[1])); } \
      resc=false; \
      if(__builtin_expect(__any(rm>(float)THRL),0)){ const float dl=(rm>(float)THRL)?rm:0.f; mhat+=dl;        \
        _Pragma("unroll") for(int r=0;r<16;++r){C0[r]-=dl;C1[r]-=dl;} \
        const float f=__builtin_amdgcn_exp2f(-dl); l_reg*=f; if(hi==0)wsf[r32]=f; resc=true; } } \
    SBAR(); \
    GAPB(o[0]=__builtin_amdgcn_mfma_f32_32x32x16_bf16(PAF(0),VFR(0),o[0],0,0,0), C0,0); \
    GAPB(o[1]=__builtin_amdgcn_mfma_f32_32x32x16_bf16(PAF(0),VFR(4),o[1],0,0,0), C0,4); \
    KRD(GL,0); GAPB(o[0]=__builtin_amdgcn_mfma_f32_32x32x16_bf16(PAF(1),VFR(1),o[0],0,0,0), C0,8); \
    KRD(GL,1); GAPB(o[1]=__builtin_amdgcn_mfma_f32_32x32x16_bf16(PAF(1),VFR(5),o[1],0,0,0), C0,12); \
    KRD(GL,2); GAPB(o[0]=__builtin_amdgcn_mfma_f32_32x32x16_bf16(PAF(2),VFR(2),o[0],0,0,0), C1,0); \
    KRD(GL,3); GAPB(o[1]=__builtin_amdgcn_mfma_f32_32x32x16_bf16(PAF(2),VFR(6),o[1],0,0,0), C1,4); \
    GAPB(o[0]=__builtin_amdgcn_mfma_f32_32x32x16_bf16(PAF(3),VFR(3),o[0],0,0,0), C1,8); \
    GAPB(o[1]=__builtin_amdgcn_mfma_f32_32x32x16_bf16(PAF(3),VFR(7),o[1],0,0,0), C1,12); \
    }while(0)
  int t=1;
  for(;t+5<NT;t+=2){
    STEP(pB0,pB1,pA0,pA1,t,true,true,true);     WAIT_BAR(2); RESC(); ROT();
    STEP(pA0,pA1,pB0,pB1,t+1,true,true,true);   WAIT_BAR(2); RESC(); ROT();
  }
  #define ENDW(tt) do{ if((tt)+3<NT){WAIT_BAR(2);} else if((tt)+2<NT){WAIT_BAR(1);} else {WAIT_BAR(0);} }while(0)
  for(;t+1<NT;t+=2){
    STEP(pB0,pB1,pA0,pA1,t,(t+3<NT),(t+1<NT),(t+1<NT));       ENDW(t);   RESC(); ROT();
    STEP(pA0,pA1,pB0,pB1,t+1,(t+4<NT),(t+2<NT),(t+2<NT));     ENDW(t+1); RESC(); ROT();
  }
  STEP(pB0,pB1,pA0,pA1,NT-1,false,false,false); RESC();
  { float sacc=pB0[0]+pB0[1]; _Pragma("unroll") for(int r=2;r<16;++r)sacc+=pB0[r]; _Pragma("unroll") for(int r=0;r<16;++r)sacc+=pB1[r]; l_reg+=sacc;
    pw0=(u32x4){PKW(pB0,0),PKW(pB0,2),PKW(pB0,4),PKW(pB0,6)};pw1=(u32x4){PKW(pB0,8),PKW(pB0,10),PKW(pB0,12),PKW(pB0,14)};pw2=(u32x4){PKW(pB1,0),PKW(pB1,2),PKW(pB1,4),PKW(pB1,6)};pw3=(u32x4){PKW(pB1,8),PKW(pB1,10),PKW(pB1,12),PKW(pB1,14)};
    SBAR(); pv(o,vb0+sl_cur,PAF(0),PAF(1),PAF(2),PAF(3)); }
  #undef PKW
  #undef PAF
  #undef VFR
  #undef PIN
  #undef MX3
  #undef GAPA
  #undef GAPB
  #undef EX
  #undef VRD
  #undef KRD
  #undef STEP
  #undef ENDW
  {auto rr=__builtin_amdgcn_permlane32_swap(__float_as_uint(l_reg),__float_as_uint(l_reg),false,false);l_reg=__uint_as_float(rr[0])+__uint_as_float(rr[1]);}
  if(hi==0)wsf[32+r32]=l_reg;asm volatile("s_waitcnt lgkmcnt(0)":::"memory");
  float rli[16];
  #pragma unroll
  for(int r=0;r<16;++r)rli[r]=__builtin_amdgcn_rcpf(wsf[32+crow(r,hi)]);
  const int slot_=valid_?(int)(((rowbase+s_)*NHEAD+h)*4+rank_):-1;
  if(hi==0){ ((int*)wsf)[r32]=slot_; if(valid_){ ML[2*(long)slot_]=mhat; ML[2*(long)slot_+1]=l_reg; } }
  { bf16*stg=(bf16*)(shm+LDS_OST)+wid*2048;
    #pragma unroll
    for(int r=0;r<16;++r){const int orow=crow(r,hi);
      #pragma unroll
      for(int d0=0;d0<2;++d0)stg[orow*64+d0*32+r32]=__float2bfloat16(o[d0][r]*rli[r]);}
    asm volatile("s_waitcnt lgkmcnt(0)":::"memory");
    #pragma unroll
    for(int i=0;i<4;++i){const int row=i*8+(lane>>3),ch=lane&7; const u32x4 v=*(const u32x4*)(stg+row*64+ch*8); const int sl_=((const int*)wsf)[row]; if(sl_>=0)ATTN_STORE16(PO+(long)sl_*64+ch*8,v);} }
  asm volatile("s_waitcnt lgkmcnt(0)\n\ts_barrier":::"memory");
  #undef DMA_K
  #undef DMA_V
  #undef CMASK
  #undef START
  #undef RESC
  #undef ROT
}
constexpr int ATTN_LDS_BYTES=LDS_BYTES;
#undef TSRC
#undef SBAR
#undef WAIT_BAR
}
constexpr int LD64 = 144, LD128 = 272;

DEV bf16x8 frag_row(const LAS unsigned char* base, int ld, int row0, int k0, int lane) { return *(const LAS bf16x8*)(base + (row0 + (lane & 31)) * ld + (k0 + 8 * (lane >> 5)) * 2); }
DEV bf16x8 frag_tr(const LAS unsigned char* base, int ld, int k0, int c0, int lane) {
    const LAS unsigned char* p = base + (k0 + 8 * (lane >> 5) + ((lane & 15) >> 2)) * ld + (c0 + 16 * ((lane >> 4) & 1) + 4 * (lane & 3)) * 2;
    const v4i16_t lo = __builtin_amdgcn_ds_read_tr16_b64_v4i16((LAS v4i16_t*)p); const v4i16_t hi = __builtin_amdgcn_ds_read_tr16_b64_v4i16((LAS v4i16_t*)(p + 4 * ld));
    return (bf16x8){lo[0], lo[1], lo[2], lo[3], hi[0], hi[1], hi[2], hi[3]};
}
template <int COLS>
DEV void stage_copy(LAS unsigned char* dst, int lld, const bf16_t* src, size_t gld, int rows, int tid) {
    constexpr int cpr = COLS / 8;
    for (int idx = tid; idx < rows * cpr; idx += NTHREADS) { const int r = idx / cpr, ch = idx % cpr; *(LAS v4u*)(dst + r * lld + ch * 16) = *(const v4u*)(src + (size_t)r * gld + ch * 8); }
}
struct Half { LAS unsigned char* L; int ht, hw, lane; };
DEV Half make_half(Frame& F) { Half H; H.L = F.lds + (F.wave >> 2) * 65536; H.ht = F.tid & 255; H.hw = F.wave & 3; H.lane = F.lane; return H; }
template <int COLS>
DEV void stage_copy_h(LAS unsigned char* dst, int lld, const bf16_t* src, size_t gld, int rows, int ht) {
    constexpr int cpr = COLS / 8;
    for (int idx = ht; idx < rows * cpr; idx += 256) { const int r = idx / cpr, ch = idx % cpr; *(LAS v4u*)(dst + r * lld + ch * 16) = *(const v4u*)(src + (size_t)r * gld + ch * 8); }
}
DEV void stage_load_h128(v4u (&v)[4], const bf16_t* src, size_t gld, int ht) {
#pragma unroll
    for (int i = 0; i < 4; ++i) { const int idx = ht + 256 * i, r = idx >> 4, ch = idx & 15; v[i] = *(const v4u*)(src + (size_t)r * gld + ch * 8); }
}
DEV void stage_store_h128(LAS unsigned char* dst, int lld, const v4u (&v)[4], int ht) {
#pragma unroll
    for (int i = 0; i < 4; ++i) { const int idx = ht + 256 * i, r = idx >> 4, ch = idx & 15; *(LAS v4u*)(dst + r * lld + ch * 16) = v[i]; }
}
#define LOADS_DONE() asm volatile("" ::: "memory")
DEV bf16x8 frag_row_g(const bf16_t* base, int ld, int row0, int k0, int lane) { return *(const bf16x8*)(base + (size_t)(row0 + (lane & 31)) * ld + k0 + 8 * (lane >> 5)); }
struct GlaCumIn { f32x4 gwv, gbv, z[4]; };
DEV void gla_cum_load(GlaCumIn& I, const Half& H, Frame& F, CArgs A, int l, size_t m0, int h) {
    const float* gw = A->in[6] + l * 16 * 256 + h * 64; const float* gb = A->in[7] + l * 256 + h * 64;
    { const int r = H.ht >> 4, c = (H.ht & 15) * 4; I.gwv = *(const f32x4*)(gw + r * 256 + c); }
    I.gbv = *(const f32x4*)(gb + (H.ht & 15) * 4);
    const float* ZS = (const float*)(F.ws + WS_ZS) + (m0 + H.lane) * 24;
#pragma unroll
    for (int q = 0; q < 4; ++q) I.z[q] = *(const f32x4*)(ZS + 4 * q);
}
DEV void gla_cum_h(const GlaCumIn& I, const Half& H, LAS float* CUM, LAS float* GWL) {
    { const int r = H.ht >> 4, c = (H.ht & 15) * 4; *(LAS f32x4*)(GWL + r * 64 + c) = I.gwv; }
    if (H.ht < 16) { const int c = H.ht * 4; *(LAS f32x4*)(GWL + 1024 + c) = I.gbv; }
    float z[16];
#pragma unroll
    for (int q = 0; q < 4; ++q) { z[4 * q] = I.z[q][0]; z[4 * q + 1] = I.z[q][1]; z[4 * q + 2] = I.z[q][2]; z[4 * q + 3] = I.z[q][3]; }
    __syncthreads();
#pragma unroll
    for (int t = 0; t < 16; ++t) { const int d = 16 * H.hw + t; float a = GWL[1024 + d];
#pragma unroll
        for (int r = 0; r < 16; ++r) a += z[r] * GWL[r * 64 + d];
        CUM[H.lane * 65 + d] = scan_add(logsigmoidf_(a) * (1.f / 16.f), H.lane); }
}
DEV void gla_local_h(const Half& H, Frame& F, CArgs A, int unit, int l) {
    const bf16_t* ZA = (const bf16_t*)(F.ws + WS_ZA); bf16_t* UG = (bf16_t*)(F.ws + WS_UG) + (size_t)unit * 128 * 64; float* DEC = (float*)(F.ws + WS_DEC) + unit * 64;
    const int bh = unit >> 7, c = unit & 127, b = bh >> 2, h = bh & 3; const size_t m0 = (size_t)b * SEQ + c * 64;
    LAS float* CUM = (LAS float*)H.L; LAS unsigned char* KE = H.L + 16640; LAS unsigned char* V = H.L + 25856; LAS float* GWL = (LAS float*)(H.L + 43264);
    v4u kk[2];
#pragma unroll
    for (int p = 0; p < 2; ++p) { const int it = H.ht + 256 * p; kk[p] = *(const v4u*)(ZA + (m0 + (it >> 3)) * ZA_LD + ZA_GK + h * 64 + (it & 7) * 8); }
    v4u vv[4]; stage_load_h128(vv, ZA + m0 * ZA_LD + ZA_GV + h * 128, ZA_LD, H.ht);
    GlaCumIn CI; gla_cum_load(CI, H, F, A, l, m0, h);
    LOADS_DONE();
    stage_store_h128(V, LD128, vv, H.ht);
    gla_cum_h(CI, H, CUM, GWL);
    __syncthreads();
#pragma unroll
    for (int p = 0; p < 2; ++p) { const int it = H.ht + 256 * p, tok = it >> 3, ch = it & 7; float f[8]; unpack8(kk[p], f);
#pragma unroll
        for (int i = 0; i < 8; ++i) f[i] *= __expf(CUM[63 * 65 + ch * 8 + i] - CUM[tok * 65 + ch * 8 + i]);
        *(LAS v4u*)(KE + tok * LD64 + ch * 16) = pack8(f); }
    if (H.ht < 64) DEC[H.ht] = __expf(CUM[63 * 65 + H.ht]);
    __syncthreads();
    { const int et = H.hw, r = H.lane & 31, hh = H.lane >> 5;
#pragma unroll
      for (int dt = 0; dt < 2; ++dt) { f32x16 acc = {};
#pragma unroll
          for (int k0 = 0; k0 < 64; k0 += 16) acc = MFMA32(frag_tr(V, LD128, k0, 32 * et, H.lane), frag_tr(KE, LD64, k0, 32 * dt, H.lane), acc);
#pragma unroll
          for (int g = 0; g < 16; ++g) UG[(32 * et + crow(g, hh)) * 64 + 32 * dt + r] = f2bf(acc[g]); } }
    __syncthreads();
}
DEV void mlstm_local_h(const Half& H, Frame& F, CArgs A, int unit, int l) {
    const bf16_t* ZA = (const bf16_t*)(F.ws + WS_ZA); const bf16_t* CQK = (const bf16_t*)(F.ws + WS_CQK2); const float* ZS = (const float*)(F.ws + WS_ZS);
    bf16_t* UG2 = (bf16_t*)(F.ws + WS_UG2) + (size_t)unit * 128 * 128; float* NU = (float*)(F.ws + WS_NU) + unit * 128;
    const int bh = unit >> 7, c = unit & 127, b = bh >> 2, h = bh & 3; const size_t m0 = (size_t)b * SEQ + c * 64;
    LAS unsigned char* KW = H.L + 1024; LAS unsigned char* V = H.L + 18432;
    v4u vvl[4]; float zs_f, zs_i;
    float kc[8][8];
    const int tg = H.ht >> 5, cc = H.ht & 31;
    { const int col = (cc < 16 ? ZA_LQ + h * 128 + cc * 8 : ZA_LK + h * 128 + (cc - 16) * 8), cch = (cc < 16 ? h * 128 + cc * 8 : 512 + h * 128 + (cc - 16) * 8);
      const int s0 = (int)(m0 & (SEQ - 1)) + 8 * tg; v4u rows[11]; stage_load_h128(vvl, ZA + m0 * ZA_LD + ZA_LV + h * 128, ZA_LD, H.ht); zs_f = ZS[(m0 + H.lane) * 24 + 20 + h]; zs_i = ZS[(m0 + H.lane) * 24 + 16 + h];
#pragma unroll
      for (int i = 0; i < 11; ++i) { const v4u zero = {0u, 0u, 0u, 0u}; rows[i] = (s0 - 3 + i >= 0) ? *(const v4u*)(ZA + (m0 + 8 * tg - 3 + i) * ZA_LD + col) : zero; }
      const float* cw = A->in[4] + l * 4 * 1024 + cch; const float* cb = A->in[5] + l * 1024 + cch; float wt[4][8], bb[8];
#pragma unroll
      for (int w = 0; w < 4; ++w) { const f32x4 t0 = *(const f32x4*)(cw + w * 1024), t1 = *(const f32x4*)(cw + w * 1024 + 4);
#pragma unroll
          for (int i = 0; i < 4; ++i) { wt[w][i] = t0[i]; wt[w][4 + i] = t1[i]; } }
      { const f32x4 t0 = *(const f32x4*)cb, t1 = *(const f32x4*)(cb + 4);
#pragma unroll
        for (int i = 0; i < 4; ++i) { bb[i] = t0[i]; bb[4 + i] = t1[i]; } }
      float fr[11][8];
#pragma unroll
      for (int i = 0; i < 11; ++i) unpack8(rows[i], fr[i]);
#pragma unroll
      for (int t = 0; t < 8; ++t) { float o[8];
#pragma unroll
          for (int i = 0; i < 8; ++i) o[i] = siluf_(bb[i] + fr[t][i] * wt[0][i] + fr[t + 1][i] * wt[1][i] + fr[t + 2][i] * wt[2][i] + fr[t + 3][i] * wt[3][i]);
          *(v4u*)(const_cast<bf16_t*>(CQK) + (m0 + 8 * tg + t) * 1024 + cch) = pack8(o);
#pragma unroll
          for (int i = 0; i < 8; ++i) kc[t][i] = bf2f(f2bf(o[i])); } }
    stage_store_h128(V, LD128, vvl, H.ht);
    const float fl = logsigmoidf_(zs_f); const float cum = scan_add(fl, H.lane); const float cl = __builtin_bit_cast(float, __builtin_amdgcn_readlane(__builtin_bit_cast(int, cum), 63));
    const float aa = cl - cum + zs_i; const float amax = wave_max(aa); const float w = __expf(aa - amax);
    if (H.ht == 0) { ((float*)(F.ws + WS_BL))[unit] = cl; ((float*)(F.ws + WS_AMAX))[unit] = amax; }
#pragma unroll
    for (int t = 0; t < 8; ++t) { const int tok = 8 * tg + t; const float wt = __shfl(w, tok) * 0.08838834764831845f; float f[8];
#pragma unroll
        for (int i = 0; i < 8; ++i) f[i] = kc[t][i] * wt;
        if (cc >= 16) *(LAS v4u*)(KW + tok * LD128 + (cc - 16) * 16) = pack8(f); }
    __syncthreads();
    { const int et = H.hw, r = H.lane & 31, hh = H.lane >> 5;
#pragma unroll
      for (int dt = 0; dt < 4; ++dt) { f32x16 acc = {};
#pragma unroll
          for (int k0 = 0; k0 < 64; k0 += 16) acc = MFMA32(frag_tr(V, LD128, k0, 32 * et, H.lane), frag_tr(KW, LD128, k0, 32 * dt, H.lane), acc);
#pragma unroll
          for (int g = 0; g < 16; ++g) UG2[(32 * et + crow(g, hh)) * 128 + 32 * dt + r] = f2bf(acc[g]); } }
    if (H.ht < 128) { float s = 0.f;
#pragma unroll 8
        for (int tok = 0; tok < 64; ++tok) s += bf2f(*(const LAS bf16_t*)(KW + tok * LD128 + H.ht * 2));
        NU[H.ht] = s; }
    __syncthreads();
}
DEV void gla_out_h(const Half& H, Frame& F, CArgs A, int unit, int l) {
    const bf16_t* ZA = (const bf16_t*)(F.ws + WS_ZA); const bf16_t* UG = (const bf16_t*)(F.ws + WS_UG) + (size_t)unit * 128 * 64; bf16_t* Y1 = (bf16_t*)(F.ws + WS_Y012) + (size_t)T * 512;
    const int bh = unit >> 7, c = unit & 127, b = bh >> 2, h = bh & 3; const size_t m0 = (size_t)b * SEQ + c * 64;
    LAS float* CUM = (LAS float*)H.L; LAS unsigned char* QD = H.L + 16640; LAS unsigned char* KI = H.L + 25856; LAS unsigned char* V = H.L + 35072; LAS unsigned char* ATT = H.L + 52480;
    LAS float* GWL = (LAS float*)(H.L + 52480);
    LAS float* O = (LAS float*)H.L;
    const int prow = H.ht >> 2, ppart = H.ht & 3;
    v4u rg[4]; { const v4u* rgp = (const v4u*)(ZA + (m0 + prow) * ZA_LD + ZA_GR + h * 128 + ppart * 32);
#pragma unroll
        for (int q = 0; q < 4; ++q) rg[q] = rgp[q]; }
    v4u q8[2], k8[2];
#pragma unroll
    for (int p = 0; p < 2; ++p) { const int it = H.ht + 256 * p; q8[p] = *(const v4u*)(ZA + (m0 + (it >> 3)) * ZA_LD + ZA_GQ + h * 64 + (it & 7) * 8); k8[p] = *(const v4u*)(ZA + (m0 + (it >> 3)) * ZA_LD + ZA_GK + h * 64 + (it & 7) * 8); }
    v4u vv[4]; stage_load_h128(vv, ZA + m0 * ZA_LD + ZA_GV + h * 128, ZA_LD, H.ht);
    GlaCumIn CI; gla_cum_load(CI, H, F, A, l, m0, h);
    bf16x8 ug[4];
#pragma unroll
    for (int k = 0; k < 4; ++k) ug[k] = frag_row_g(UG, 64, 32 * H.hw, 16 * k, H.lane);
    LOADS_DONE();
    stage_store_h128(V, LD128, vv, H.ht);
    gla_cum_h(CI, H, CUM, GWL);
    __syncthreads();
#pragma unroll
    for (int p = 0; p < 2; ++p) { const int it = H.ht + 256 * p, tok = it >> 3, ch = it & 7; float fq[8], fk[8]; unpack8(q8[p], fq); unpack8(k8[p], fk);
#pragma unroll
        for (int i = 0; i < 8; ++i) { const float cv = CUM[tok * 65 + ch * 8 + i]; fq[i] *= 0.125f * __expf(cv); fk[i] *= __expf(-cv); }
        *(LAS v4u*)(QD + tok * LD64 + ch * 16) = pack8(fq); *(LAS v4u*)(KI + tok * LD64 + ch * 16) = pack8(fk); }
    __syncthreads();
    const int r = H.lane & 31, hh = H.lane >> 5;
    { const int it = H.hw >> 1, jt = H.hw & 1; f32x16 acc = {};
      if (!(it == 0 && jt == 1)) {
#pragma unroll
          for (int k0 = 0; k0 < 64; k0 += 16) acc = MFMA32(frag_row(QD, LD64, 32 * it, k0, H.lane), frag_row(KI, LD64, 32 * jt, k0, H.lane), acc); }
#pragma unroll
      for (int g = 0; g < 16; ++g) { const int i = 32 * it + crow(g, hh), j = 32 * jt + r; *(LAS bf16_t*)(ATT + i * LD64 + j * 2) = f2bf(j <= i ? acc[g] : 0.f); } }
    __syncthreads();
    f32x16 oacc[2];
    { const int et = H.hw;
#pragma unroll
      for (int it = 0; it < 2; ++it) { f32x16 acc = {};
#pragma unroll
          for (int k0 = 0; k0 < 64; k0 += 16) acc = MFMA32(frag_row(ATT, LD64, 32 * it, k0, H.lane), frag_tr(V, LD128, k0, 32 * et, H.lane), acc);
#pragma unroll
          for (int k0 = 0; k0 < 64; k0 += 16) acc = MFMA32(frag_row(QD, LD64, 32 * it, k0, H.lane), ug[k0 >> 4], acc);
          oacc[it] = acc; } }
    __syncthreads();
#pragma unroll
    for (int it = 0; it < 2; ++it)
#pragma unroll
        for (int g = 0; g < 16; ++g) O[(32 * it + crow(g, hh)) * 132 + 32 * H.hw + r] = oacc[it][g];
    __syncthreads();
    { const float* gn = A->in[8] + l * 512 + h * 128 + ppart * 32; float x[32]; float ss = 0.f;
#pragma unroll
      for (int q = 0; q < 8; ++q) { const f32x4 t = *(const LAS f32x4*)(O + prow * 132 + ppart * 32 + 4 * q); x[4 * q] = t[0]; x[4 * q + 1] = t[1]; x[4 * q + 2] = t[2]; x[4 * q + 3] = t[3]; ss += t[0] * t[0] + t[1] * t[1] + t[2] * t[2] + t[3] * t[3]; }
      ss += __shfl_xor(ss, 1); ss += __shfl_xor(ss, 2);
      const float sc = rsqrtf(ss * (1.f / 128.f) + EPS); v4u* yp = (v4u*)(Y1 + (m0 + prow) * 512 + h * 128 + ppart * 32);
#pragma unroll
      for (int q = 0; q < 4; ++q) { float gt[8], y[8]; unpack8(rg[q], gt); const f32x4 g0 = *(const f32x4*)(gn + 8 * q), g1 = *(const f32x4*)(gn + 8 * q + 4);
#pragma unroll
          for (int i = 0; i < 4; ++i) { y[i] = x[8 * q + i] * sc * g0[i] * siluf_(gt[i]); y[4 + i] = x[8 * q + 4 + i] * sc * g1[i] * siluf_(gt[4 + i]); }
          yp[q] = pack8(y); } }
    __syncthreads();
}
DEV void mlstm_out_h(const Half& H, Frame& F, int unit) {
    const bf16_t* ZA = (const bf16_t*)(F.ws + WS_ZA); const bf16_t* CQK = (const bf16_t*)(F.ws + WS_CQK2); const float* ZS = (const float*)(F.ws + WS_ZS);
    const bf16_t* UG2 = (const bf16_t*)(F.ws + WS_UG2) + (size_t)unit * 128 * 128; const float* NP = (const float*)(F.ws + WS_NU) + unit * 128; bf16_t* Y2 = (bf16_t*)(F.ws + WS_Y012) + (size_t)2 * T * 512;
    const int bh = unit >> 7, c = unit & 127, b = bh >> 2, h = bh & 3; const size_t m0 = (size_t)b * SEQ + c * 64;
    LAS float* AR = (LAS float*)H.L;
    LAS unsigned char* Q = H.L + 2048; LAS unsigned char* K = H.L + 19456; LAS unsigned char* V = H.L + 36864; LAS unsigned char* WI = H.L + 54272;
    LAS float* O = (LAS float*)(H.L + 2048);
    const int prow = H.ht >> 2, ppart = H.ht & 3;
    v4u og[4]; { const v4u* ogp = (const v4u*)(ZA + (m0 + prow) * ZA_LD + ZA_LO + h * 128 + ppart * 32);
#pragma unroll
        for (int q = 0; q < 4; ++q) og[q] = ogp[q]; }
    f32x4 npv = {0.f, 0.f, 0.f, 0.f}; if (H.ht < 32) npv = *(const f32x4*)(NP + 4 * H.ht);
    v4u kk[4];
#pragma unroll
    for (int p = 0; p < 4; ++p) { const int tok = (H.ht >> 4) + 16 * p, ch = H.ht & 15; kk[p] = *(const v4u*)(CQK + (m0 + tok) * 1024 + 512 + h * 128 + ch * 8); }
    v4u vq[4], vv[4]; stage_load_h128(vq, CQK + m0 * 1024 + h * 128, 1024, H.ht); stage_load_h128(vv, ZA + m0 * ZA_LD + ZA_LV + h * 128, ZA_LD, H.ht);
    const float zs_f = ZS[(m0 + H.lane) * 24 + 20 + h], zs_i = ZS[(m0 + H.lane) * 24 + 16 + h], mp = ((const float*)(F.ws + WS_MPREV))[unit];
    bf16x8 ug[8];
#pragma unroll
    for (int k = 0; k < 8; ++k) ug[k] = frag_row_g(UG2, 128, 32 * H.hw, 16 * k, H.lane);
    LOADS_DONE();
    stage_store_h128(Q, LD128, vq, H.ht); stage_store_h128(V, LD128, vv, H.ht); if (H.ht < 32) *(LAS f32x4*)(AR + 384 + 4 * H.ht) = npv;
    if (H.hw == 0) { const float fl = logsigmoidf_(zs_f); const float cum = scan_add(fl, H.lane); const float g = zs_i - cum;
        const float pm = scan_max(g, H.lane); const float mx = fmaxf(mp, pm);
        AR[H.lane] = cum; AR[64 + H.lane] = g; AR[128 + H.lane] = mx; AR[192 + H.lane] = __expf(mp - mx); }
#pragma unroll
    for (int p = 0; p < 4; ++p) { const int tok = (H.ht >> 4) + 16 * p, ch = H.ht & 15; float f[8]; unpack8(kk[p], f);
#pragma unroll
        for (int i = 0; i < 8; ++i) f[i] *= 0.08838834764831845f;
        *(LAS v4u*)(K + tok * LD128 + ch * 16) = pack8(f); }
    __syncthreads();
    const int r = H.lane & 31, hh = H.lane >> 5;
    { const int it = H.hw >> 1, jt = H.hw & 1; f32x16 acc = {};
      if (!(it == 0 && jt == 1)) {
#pragma unroll
          for (int k0 = 0; k0 < 128; k0 += 16) acc = MFMA32(frag_row(Q, LD128, 32 * it, k0, H.lane), frag_row(K, LD128, 32 * jt, k0, H.lane), acc); }
      const int j = 32 * jt + r; const float gj = AR[64 + j];
#pragma unroll
      for (int g = 0; g < 16; ++g) { const int i = 32 * it + crow(g, hh); *(LAS bf16_t*)(WI + i * LD64 + j * 2) = f2bf(j <= i ? acc[g] * __expf(gj - AR[128 + i]) : 0.f); } }
    { float a = 0.f;
#pragma unroll
      for (int q = 0; q < 4; ++q) { float f[8]; unpack8(*(const LAS v4u*)(Q + prow * LD128 + ppart * 64 + q * 16), f); const f32x4 n0 = *(const LAS f32x4*)(AR + 384 + ppart * 32 + q * 8), n1 = *(const LAS f32x4*)(AR + 384 + ppart * 32 + q * 8 + 4);
          a += f[0] * n0[0] + f[1] * n0[1] + f[2] * n0[2] + f[3] * n0[3] + f[4] * n1[0] + f[5] * n1[1] + f[6] * n1[2] + f[7] * n1[3]; }
      a += __shfl_xor(a, 1); a += __shfl_xor(a, 2); if (ppart == 0) AR[256 + prow] = a; }
    __syncthreads();
    { float sw = 0.f;
#pragma unroll
      for (int q = 0; q < 2; ++q) { float f[8]; unpack8(*(const LAS v4u*)(WI + prow * LD64 + ppart * 32 + q * 16), f); sw += ((f[0] + f[1]) + (f[2] + f[3])) + ((f[4] + f[5]) + (f[6] + f[7])); }
      sw += __shfl_xor(sw, 1); sw += __shfl_xor(sw, 2);
      if (ppart == 0) { const float den = AR[192 + prow] * AR[256 + prow] + sw; AR[320 + prow] = __builtin_amdgcn_rcpf(fmaxf(fabsf(den), __expf(-(AR[prow] + AR[128 + prow])))); } }
    f32x16 oacc[2];
    { const int et = H.hw;
#pragma unroll
      for (int it = 0; it < 2; ++it) { f32x16 acc = {};
#pragma unroll
          for (int k0 = 0; k0 < 128; k0 += 16) acc = MFMA32(frag_row(Q, LD128, 32 * it, k0, H.lane), ug[k0 >> 4], acc);
#pragma unroll
          for (int g = 0; g < 16; ++g) acc[g] *= AR[192 + 32 * it + crow(g, hh)];
#pragma unroll
          for (int k0 = 0; k0 < 64; k0 += 16) acc = MFMA32(frag_row(WI, LD64, 32 * it, k0, H.lane), frag_tr(V, LD128, k0, 32 * et, H.lane), acc);
          oacc[it] = acc; } }
    __syncthreads();
#pragma unroll
    for (int it = 0; it < 2; ++it)
#pragma unroll
        for (int g = 0; g < 16; ++g) O[(32 * it + crow(g, hh)) * 132 + 32 * H.hw + r] = oacc[it][g];
    __syncthreads();
    { const float rd = AR[320 + prow]; v4u* yp = (v4u*)(Y2 + (m0 + prow) * 512 + h * 128 + ppart * 32);
#pragma unroll
      for (int q = 0; q < 4; ++q) { float gt[8], y[8]; unpack8(og[q], gt); const f32x4 t0 = *(const LAS f32x4*)(O + prow * 132 + ppart * 32 + 8 * q), t1 = *(const LAS f32x4*)(O + prow * 132 + ppart * 32 + 8 * q + 4);
#pragma unroll
          for (int i = 0; i < 4; ++i) { y[i] = t0[i] * rd * sigmoidf_(gt[i]); y[4 + i] = t1[i] * rd * sigmoidf_(gt[4 + i]); }
          yp[q] = pack8(y); } }
    __syncthreads();
}
typedef float f32x2 __attribute__((ext_vector_type(2)));
DEV void p_mixer_scan(Frame& F) {
    if (F.vcu < 64) {
        const int gt = F.vcu * NTHREADS + F.tid, bh = gt >> 12, e = (gt >> 5) & 127, dp = gt & 31; unsigned* U = (unsigned*)(F.ws + WS_UG) + ((size_t)bh * 128 * 128 + e) * 32 + dp;
        unsigned u[128];
        { const unsigned* pl = U;
#pragma unroll
          for (int c = 0; c < 128; ++c) { u[c] = *pl; pl += 128 * 32; } }
        LAS float* DL = (LAS float*)F.lds;
        { const f32x4* dsrc = (const f32x4*)((const float*)(F.ws + WS_DEC) + bh * 128 * 64); f32x4 dv[4];
#pragma unroll
          for (int i = 0; i < 4; ++i) dv[i] = dsrc[F.tid + 512 * i];
#pragma unroll
          for (int i = 0; i < 4; ++i) ((LAS f32x4*)DL)[F.tid + 512 * i] = dv[i]; }
        __syncthreads();
        float s0 = 0.f, s1 = 0.f;
        unsigned* ps = U; asm volatile("" : "+v"(ps));
#pragma unroll
        for (int c = 0; c < 128; ++c) { const f32x2 dd = *(const LAS f32x2*)(DL + c * 64 + 2 * dp); *ps = pk2(s0, s1); ps += 128 * 32; s0 = dd.x * s0 + __uint_as_float(u[c] << 16); s1 = dd.y * s1 + __uint_as_float(u[c] & 0xffff0000u); }
    } else if (F.vcu < 192) {
        const int q = (F.vcu - 64) * NTHREADS + F.tid, bh = q >> 13, e = (q >> 6) & 127, dp = q & 63; unsigned* U = (unsigned*)(F.ws + WS_UG2) + ((size_t)bh * 128 * 128 + e) * 64 + dp; const bool firstwg = ((F.vcu - 64) & 15) == 0;
        unsigned u[128];
        { const unsigned* pl = U;
#pragma unroll
          for (int c = 0; c < 128; ++c) { u[c] = *pl; pl += 128 * 64; } }
        LAS float* AB = (LAS float*)F.lds;
        LAS float* MB = AB + 256; LAS float* NL = (LAS float*)(F.lds + 4096);
        float* NU = (float*)(F.ws + WS_NU) + (size_t)bh * 128 * 128;
        f32x4 nv[8];
        if (firstwg) {
#pragma unroll
            for (int i = 0; i < 8; ++i) nv[i] = ((const f32x4*)NU)[F.tid + 512 * i]; }
        if (F.wave == 0) {
            const f32x2 bl = *(const f32x2*)((const float*)(F.ws + WS_BL) + bh * 128 + 2 * F.lane), am = *(const f32x2*)((const float*)(F.ws + WS_AMAX) + bh * 128 + 2 * F.lane);
            const float pin = scan_add(bl.x + bl.y, F.lane), p1 = pin, p0 = pin - bl.y;
            const float g0 = am.x - p0, g1 = am.y - p1; const float xin = scan_max(fmaxf(g0, g1), F.lane);
            float xprev = __shfl_up(xin, 1); if (F.lane == 0) xprev = 0.f; xprev = fmaxf(xprev, 0.f);
            const float x0 = fmaxf(xprev, g0), x1 = fmaxf(x0, g1);
            float pprev = __shfl_up(pin, 1); if (F.lane == 0) pprev = 0.f;
            const float mb0 = pprev + xprev, m0 = p0 + x0, m1 = p1 + x1;
            *(LAS f32x4*)(AB + 4 * F.lane) = (f32x4){__expf(bl.x + mb0 - m0), __expf(am.x - m0), __expf(bl.y + m0 - m1), __expf(am.y - m1)};
            *(LAS f32x2*)(MB + 2 * F.lane) = (f32x2){mb0, m0}; }
        if (firstwg) {
#pragma unroll
            for (int i = 0; i < 8; ++i) ((LAS f32x4*)NL)[F.tid + 512 * i] = nv[i]; }
        __syncthreads();
        float s0 = 0.f, s1 = 0.f;
        unsigned* ps = U; asm volatile("" : "+v"(ps));
#pragma unroll
        for (int c = 0; c < 128; ++c) { const f32x2 ab = *(const LAS f32x2*)(AB + 2 * c); *ps = pk2(s0, s1); ps += 128 * 64; s0 = ab.x * s0 + ab.y * __uint_as_float(u[c] << 16); s1 = ab.x * s1 + ab.y * __uint_as_float(u[c] & 0xffff0000u); }
        if (firstwg && F.wave == 0) { float n0 = 0.f, n1 = 0.f; float* MP = (float*)(F.ws + WS_MPREV) + bh * 128;
#pragma unroll 8
            for (int c = 0; c < 128; ++c) { const f32x2 ab = *(const LAS f32x2*)(AB + 2 * c), nu = *(const LAS f32x2*)(NL + c * 128 + 2 * F.lane);
                *(f32x2*)(NU + c * 128 + 2 * F.lane) = (f32x2){n0, n1}; n0 = ab.x * n0 + ab.y * nu.x; n1 = ab.x * n1 + ab.y * nu.y; if (F.lane == 0) MP[c] = MB[c]; } }
    }
}


constexpr size_t WS_PO = 105 * MiB;
constexpr size_t WS_ML = 169 * MiB;
constexpr size_t WS_LIST = 186 * MiB;
constexpr int CW_MCNT = 8192;
DEV void p_moba_select(Frame& F, int l) {
    const bf16_t* ZA = (const bf16_t*)(F.ws + WS_ZA); const float* KM = (const float*)(F.ws + WS_KM); unsigned* cnt = (unsigned*)(F.ws + WS_CTL) + CW_MCNT + l * 512; unsigned short* lists = (unsigned short*)(F.ws + WS_LIST);
    LAS float* kmL = (LAS float*)(F.lds + 65536);
    for (int w = F.gw; w < 2048; w += F.NGW) { const int bh = w >> 7, qb = (w >> 2) & 31, s = qb * 256 + (w & 3) * 64 + F.lane, b = bh >> 3, h = bh & 7;
        __syncthreads(); ((LAS f32x4*)kmL)[F.tid] = ((const f32x4*)(KM + (size_t)bh * 2048))[F.tid]; __syncthreads();
        if (qb == 0) continue;
        int i0 = 0, i1 = 1, i2 = 2;
        if (qb > 3) { float q[64]; const v4u* qp = (const v4u*)(ZA + ((size_t)b * SEQ + s) * ZA_LD + ZA_MQ + h * 64);
#pragma unroll
            for (int c = 0; c < 8; ++c) { float f[8]; unpack8(qp[c], f);
#pragma unroll
                for (int i = 0; i < 8; ++i) q[c * 8 + i] = f[i]; }
            { const float* cs = (const float*)(F.ws + WS_ROPE_COS) + s * 8; const float* sn = (const float*)(F.ws + WS_ROPE_SIN) + s * 8;
#pragma unroll
              for (int d = 0; d < 8; ++d) { const float x1 = q[d], x2 = q[8 + d], c = cs[d], sv = sn[d]; q[d] = x1 * c - x2 * sv; q[8 + d] = x2 * c + x1 * sv; } }
            float b0 = -INFINITY, b1 = -INFINITY, b2 = -INFINITY;
            for (int j = 0; j < qb; ++j) { float a = 0.f;
#pragma unroll
                for (int d4 = 0; d4 < 16; ++d4) { const f32x4 kv = ((const LAS f32x4*)(kmL + j * 64))[d4]; a += q[4 * d4] * kv[0] + q[4 * d4 + 1] * kv[1] + q[4 * d4 + 2] * kv[2] + q[4 * d4 + 3] * kv[3]; }
                const bool g0 = a > b0, g1 = a > b1, g2 = a > b2;
                i2 = g1 ? i1 : (g2 ? j : i2); b2 = g1 ? b1 : (g2 ? a : b2);
                i1 = g0 ? i0 : (g1 ? j : i1); b1 = g0 ? b0 : (g1 ? a : b1);
                i0 = g0 ? j : i0; b0 = g0 ? a : b0; } }
        const int nsel = qb < 3 ? qb : 3; const unsigned long long lt = (1ull << F.lane) - 1ull;
        unsigned mytot = 0u;
        for (int jj = 0; jj < qb; ++jj) { const bool p0 = nsel > 0 && i0 == jj, p1 = nsel > 1 && i1 == jj, p2 = nsel > 2 && i2 == jj;
            const unsigned tot = (unsigned)(__popcll(__ballot(p0)) + __popcll(__ballot(p1)) + __popcll(__ballot(p2))); mytot = (F.lane == jj) ? tot : mytot; }
        unsigned mybase = 0u; if (F.lane < qb && mytot > 0u) mybase = __hip_atomic_fetch_add(cnt + bh * 32 + F.lane, mytot, __ATOMIC_RELAXED, __HIP_MEMORY_SCOPE_AGENT);
        for (int jj = 0; jj < qb; ++jj) {
            const bool p0 = nsel > 0 && i0 == jj, p1 = nsel > 1 && i1 == jj, p2 = nsel > 2 && i2 == jj;
            const unsigned long long m0 = __ballot(p0), m1 = __ballot(p1), m2 = __ballot(p2); const int c0 = __popcll(m0), c1 = __popcll(m1);
            const unsigned base = (unsigned)__builtin_amdgcn_readlane((int)mybase, jj);
            unsigned short* lp = lists + (size_t)(bh * 32 + jj) * 8192 + base;
            if (p0) lp[__popcll(m0 & lt)] = (unsigned short)s;
            if (p1) lp[c0 + __popcll(m1 & lt)] = (unsigned short)(s | (1 << 13));
            if (p2) lp[c0 + c1 + __popcll(m2 & lt)] = (unsigned short)(s | (2 << 13)); }
    }
}
DEV void p_moba_sparse(Frame& F, int l) {
    const attn_body::bf16* ZAb = (const attn_body::bf16*)(F.ws + WS_ZA); attn_body::bf16* PO = (attn_body::bf16*)(F.ws + WS_PO); float* ML = (float*)(F.ws + WS_ML);
    const unsigned* cnt = (const unsigned*)(F.ws + WS_CTL) + CW_MCNT + l * 512; const unsigned short* lists = (const unsigned short*)(F.ws + WS_LIST);
    LAS int* pre = (LAS int*)(F.lds + 98304);
    const float* rcs = (const float*)(F.ws + WS_ROPE_COS); const float* rsn = (const float*)(F.ws + WS_ROPE_SIN);
    if (F.wave == 0) { int v[8]; int sum = 0;
#pragma unroll
        for (int i = 0; i < 8; ++i) { v[i] = sum; sum += (int)((cnt[8 * F.lane + i] + 255u) >> 8); }
        const int excl = (int)scan_add((float)sum, F.lane) - sum;
#pragma unroll
        for (int i = 0; i < 8; ++i) pre[8 * F.lane + i] = excl + v[i];
        if (F.lane == 63) pre[512] = excl + sum; }
    __syncthreads();
    const int U = 512 + pre[512];
    for (int k = F.vcu; k < U; k += F.G) {
        if (k < 512) { const int bh = k >> 5, j = k & 31; attn_body::attn_unit<8, true>(F.tid, bh >> 3, bh & 7, j, nullptr, 0, 0, ZAb + ZA_MQ, ZAb + ZA_MK, ZAb + ZA_MV, PO, ML, rcs, rsn, (char*)F.ldsg); }
        else { const int p = k - 512; int lo = 0, hi = 512; while (hi - lo > 1) { const int mid = (lo + hi) >> 1; if (pre[mid] <= p) lo = mid; else hi = mid; }
            const int t = lo, bh = t >> 5, j = t & 31; attn_body::attn_unit<8, false>(F.tid, bh >> 3, bh & 7, j, lists + (size_t)t * 8192, p - pre[t], (int)cnt[t], ZAb + ZA_MQ, ZAb + ZA_MK, ZAb + ZA_MV, PO, ML, rcs, rsn, (char*)F.ldsg); }
    }
}
DEV void p_moba_combine(Frame& F) {
    const bf16_t* PO = (const bf16_t*)(F.ws + WS_PO); const float* ML = (const float*)(F.ws + WS_ML); bf16_t* Y0 = (bf16_t*)(F.ws + WS_Y012);
    const int NTc = F.G * NTHREADS;
    for (int idx0 = F.vcu * NTHREADS + F.tid; idx0 < T * 64; idx0 += 2 * NTc) { float mm[2][4], ll[2][4]; v4u ov[2][4];
#pragma unroll
        for (int u = 0; u < 2; ++u) { const int idx = idx0 + u * NTc, ch = idx & 7, mh = idx >> 3, m = mh >> 3, qb = (m & (SEQ - 1)) >> 8, nsel = qb < 3 ? qb : 3;
#pragma unroll
            for (int r = 0; r < 4; ++r) { const bool on = idx < T * 64 && ((r == 3) || (r < nsel)); const size_t sl = (size_t)mh * 4 + r; const float2 t = on ? *(const float2*)(ML + 2 * sl) : make_float2(-INFINITY, 0.f); mm[u][r] = t.x; ll[u][r] = t.y;
                const v4u z = {0u, 0u, 0u, 0u}; ov[u][r] = on ? *(const v4u*)(PO + sl * 64 + ch * 8) : z; } }
#pragma unroll
        for (int u = 0; u < 2; ++u) { const int idx = idx0 + u * NTc, ch = idx & 7, mh = idx >> 3; if (idx >= T * 64) break;
            const float M = fmaxf(fmaxf(mm[u][0], mm[u][1]), fmaxf(mm[u][2], mm[u][3])); float wsum = 0.f, acc[8];
#pragma unroll
            for (int i = 0; i < 8; ++i) acc[i] = 0.f;
#pragma unroll
            for (int r = 0; r < 4; ++r) { const float w = ll[u][r] * __builtin_amdgcn_exp2f(mm[u][r] - M); wsum += w; float f[8]; unpack8(ov[u][r], f);
#pragma unroll
                for (int i = 0; i < 8; ++i) acc[i] += w * f[i]; }
            const float inv = __builtin_amdgcn_rcpf(wsum);
#pragma unroll
            for (int i = 0; i < 8; ++i) acc[i] *= inv;
            *(v4u*)(Y0 + (size_t)mh * 64 + ch * 8) = pack8(acc); } }
}

constexpr int N_PHASES = 26;
#ifndef REPEAT_MASK
#define REPEAT_MASK 0u
#endif
__global__ void __launch_bounds__(NTHREADS, 2) fwd(const Args A_) {
    extern __shared__ __attribute__((aligned(16))) unsigned char lds[];
    volatile LAS unsigned* MISC = (volatile LAS unsigned*)((LAS unsigned char*)lds + MISC_OFF);
    for (int u = threadIdx.x; u < (LDS_BYTES - LDSCTL_OFF) / 4; u += NTHREADS) ((LAS unsigned*)((LAS unsigned char*)lds + LDSCTL_OFF))[u] = 0u;
    __syncthreads();
    XcdBarrier bar = xcd_barrier_post((unsigned*)(A_.ws + WS_CTL) + CW_BAR, MISC + 8);
    const int lo = A_.ph_lo, hi = A_.ph_hi; int ph = 0;
    const unsigned wave_id_ = __builtin_amdgcn_readfirstlane(threadIdx.x >> 6);
#define PHASE_BEGIN if (lo <= ph && ph < hi) { const int nrep_ = 1 + (int)((REPEAT_MASK >> ph) & 1u); for (int rep_ = 0; rep_ < nrep_; ++rep_) { Frame F; CArgs A; { unsigned wv_ = wave_id_; asm volatile("" : "+s"(wv_)); unsigned t_ = (wv_ << 6) | __builtin_amdgcn_mbcnt_hi(~0u, __builtin_amdgcn_mbcnt_lo(~0u, 0u)); asm volatile("" : "+v"(t_)); unsigned bx_ = blockIdx.x; asm volatile("" : "+s"(bx_)); \
        unsigned long long ka_ = (unsigned long long)__builtin_amdgcn_kernarg_segment_ptr(); asm volatile("" : "+s"(ka_)); A = (CArgs)ka_; \
        F.lds = (LAS unsigned char*)lds; F.ldsg = lds; F.tid = (int)t_; F.lane = F.tid & 63; F.wave = __builtin_amdgcn_readfirstlane(F.tid >> 6); F.G = gridDim.x; F.bx = (int)bx_; \
        F.vcu = (F.G % 8 == 0) ? (F.bx % 8) * (F.G / 8) + F.bx / 8 : F.bx; F.gw = F.vcu * NWAVES + F.wave; F.NGW = F.G * NWAVES; unsigned long long z_ = 0ull; asm volatile("" : "+s"(z_)); F.X = A_.out + z_; F.ws = A_.ws + z_; } \
        unsigned char* ws = F.ws; bf16_t* XN = (bf16_t*)(ws + WS_XN); bf16_t* ZA = (bf16_t*)(ws + WS_ZA); bf16_t* ZG = (bf16_t*)(ws + WS_ZG); float* ZS = (float*)(ws + WS_ZS); \
        bf16_t* Y012 = (bf16_t*)(ws + WS_Y012); bf16_t* U = (bf16_t*)(ws + WS_U); bf16_t* HD = (bf16_t*)(ws + WS_HD); (void)XN; (void)ZA; (void)ZG; (void)ZS; (void)Y012; (void)U; (void)HD;
#define REFRAME() do { asm volatile("" : "+v"(F.tid)); F.lane = F.tid & 63; F.wave = __builtin_amdgcn_readfirstlane(F.tid >> 6); asm volatile("" : "+s"(F.vcu)); F.gw = F.vcu * NWAVES + F.wave; \
        unsigned long long z2_ = 0ull; asm volatile("" : "+s"(z2_)); F.ws = F.ws + z2_; } while (0)
#define PHASE_END   if (ph + 1 < hi || rep_ + 1 < nrep_) { XcdBarrier b_ = bar; asm volatile("" : "+s"(b_.x)); unsigned long long p_ = (unsigned long long)b_.bar; asm volatile("" : "+s"(p_)); b_.bar = (unsigned*)p_; xcd_barrier(b_); } } } ++ph;

    PHASE_BEGIN
        p_rope_table(F); p_sample_moe_amax(F, A); p_prep_small_weights(F, A); __syncthreads();
        p_norm<24>(F, A->in[0], A->in[1], XN, A->in[2], NIN, 2560, 4624, A->in[3], ZS, nullptr, nullptr);
    PHASE_END
    { constexpr int l = 0;
        if (l == 1) {
            PHASE_BEGIN
                p_norm<24, true>(F, (const float*)(ws + WS_XB), A->in[1] + D, XN, A->in[2] + (size_t)D * NIN, NIN, 2560, 4624, A->in[3] + NIN, ZS, nullptr, nullptr);
            PHASE_END
        }
        PHASE_BEGIN
            pg8::Sched S; S.init(T / 256, 20, F.G, F.bx, XN, D, (bf16_t*)(ws + WS_WIN) + (size_t)l * 8192 * 1024, D);
            pg8::EpiInproj E{ZA, ZG, A->in[3] + l * NIN};
            pg8::gemm_phase<pg8::EpiInproj, pg8::Sched, true, true>(F.lds, F.tid, D, D, D, S, E);
        PHASE_END
        PHASE_BEGIN
            p_mixer_prep(F, A, l);
            REFRAME();
            { const Half H = make_half(F); for (int u = F.vcu + (F.wave >> 2) * F.G; u < 1024; u += 2 * F.G) gla_local_h(H, F, A, u, l); }
            REFRAME();
            { const Half H = make_half(F); for (int u = F.vcu + (F.wave >> 2) * F.G; u < 1024; u += 2 * F.G) mlstm_local_h(H, F, A, u, l); }
        PHASE_END
        PHASE_BEGIN
            p_mixer_scan(F);
            REFRAME();
            p_moba_select(F, l);
        PHASE_END
        PHASE_BEGIN
            { const Half H = make_half(F); for (int u = F.vcu + (F.wave >> 2) * F.G; u < 1024; u += 2 * F.G) gla_out_h(H, F, A, u, l); }
            REFRAME();
            { const Half H = make_half(F); for (int u = F.vcu + (F.wave >> 2) * F.G; u < 1024; u += 2 * F.G) mlstm_out_h(H, F, u); }
        PHASE_END
        PHASE_BEGIN
            p_moba_sparse(F, l);
        PHASE_END
        PHASE_BEGIN
            p_moba_combine(F);
            REFRAME();
            pg8::Sched S; S.init(T / 256, 12, F.G, F.bx, XN, D, (bf16_t*)(ws + WS_WIN) + (size_t)l * 8192 * 1024, D); S.pn0 = 20;
            pg8::EpiInproj E{ZA, ZG, A->in[3] + l * NIN};
            pg8::gemm_phase<pg8::EpiInproj, pg8::Sched, true, true>(F.lds, F.tid, D, D, D, S, E);
        PHASE_END
        PHASE_BEGIN
            pg8::Sched S; S.init(T / 256, 4, F.G, F.bx, Y012, 512, (bf16_t*)(ws + WS_WUP) + (size_t)l * 3072 * 512, 512); S.a_split_tiles = 4; S.a_split_bytes = (size_t)T * 512 * 2; S.branch3 = 1;
            pg8::EpiUpGate E{U, ZG};
            pg8::gemm_phase<pg8::EpiUpGate, pg8::Sched, true, true>(F.lds, F.tid, 512, 512, 512, S, E);
        PHASE_END
        PHASE_BEGIN
            pg8::Sched S; S.init(T / 256, D / 256, F.G, F.bx, U, D, (bf16_t*)(ws + WS_WO3) + (size_t)l * 1024 * 1024, D);
            if (l == 0) { pg8::EpiResidT<false, true> E{A->in[0], ws + WS_XB}; pg8::gemm_phase<pg8::EpiResidT<false, true>, pg8::Sched, true, true>(F.lds, F.tid, D, D, D, S, E); }
            else { pg8::EpiResidT<true, false> E{ws + WS_XB, F.X}; pg8::gemm_phase<pg8::EpiResidT<true, false>, pg8::Sched, true, true>(F.lds, F.tid, D, D, D, S, E); }
        PHASE_END
        if (l == 0) {
            PHASE_BEGIN
                p_norm<0, true>(F, (const float*)(ws + WS_XB), A->in[13], XN, nullptr, 0, 0, 0, nullptr, nullptr, nullptr, nullptr);
            PHASE_END
            PHASE_BEGIN
                pg8::EpiSwiglu E{HD}; const int units = (T / 256) * 22, R = units / F.G, Lc = units - R * F.G; const bool hs = Lc > 0 && 2 * Lc <= F.G && R > 0;
                { pg8::Sched S; S.init(T / 256, 5632 / 256, F.G, F.bx, XN, D, ws + WS_WFGU, D); if (hs) S.lim = R * F.G;
                  pg8::gemm_phase<pg8::EpiSwiglu, pg8::Sched, true, true>(F.lds, F.tid, D, D, D, S, E); }
                if (hs) { pg8::Sched S; S.init(T / 256, 5632 / 256, F.G, F.bx, XN, D, ws + WS_WFGU, D); S.first = R * F.G; S.nhalf = Lc;
                  pg8::gemm_phase<pg8::EpiSwiglu, pg8::Sched, true, true, true>(F.lds, F.tid, D, D, D, S, E); }
            PHASE_END
            PHASE_BEGIN
                pg8::Sched S; S.init(T / 256, D / 256, F.G, F.bx, HD, DFF, ws + WS_WFD, DFF);
                pg8::EpiResidT<true, true> E{ws + WS_XB, ws + WS_XB};
                pg8::gemm_phase<pg8::EpiResidT<true, true>, pg8::Sched, true, true>(F.lds, F.tid, DFF, DFF, DFF, S, E);
            PHASE_END
        } else {
            PHASE_BEGIN
                p_prep_moe_weights(F, A); __syncthreads();
                p_norm<8, false, true>(F, F.X, A->in[13] + D, (bf16_t*)(ws + WS_XN2), A->in[17], 8, 0, 0, A->in[18], nullptr, (int*)(ws + WS_TOPE), (float*)(ws + WS_TOPG));
            PHASE_END
            PHASE_BEGIN
                p_route_gather(F);
            PHASE_END
            PHASE_BEGIN
                const int nb = *(const int*)(ws + WS_NBLK);
                const float* wam = (const float*)(ws + WS_CTL) + CW_WAMAX;
                pg8::EpiSwigluQ E{(bf16_t*)(ws + WS_HM), (const float*)(ws + WS_RSG), 1.f / pow2_scale(wam[0]), 1.f / pow2_scale(wam[64])}; const int units = nb * 22, R = units / F.G, Lc = units - R * F.G; const bool hs = Lc > 0 && 2 * Lc <= F.G && R > 0;
                { pg8::Sched S; S.init(nb, 5632 / 256, F.G, F.bx, ws + WS_YM, D / 2, ws + WS_MGU, D / 2); S.blk_e = (const int*)(ws + WS_BLK_E); S.b_estride = (size_t)5632 * 1024; if (hs) S.lim = R * F.G;
                  pg8::gemm_phase<pg8::EpiSwigluQ, pg8::Sched, true, true, false, 1>(F.lds, F.tid, D / 2, D / 2, D / 2, S, E); }
                if (hs) { pg8::Sched S; S.init(nb, 5632 / 256, F.G, F.bx, ws + WS_YM, D / 2, ws + WS_MGU, D / 2); S.blk_e = (const int*)(ws + WS_BLK_E); S.b_estride = (size_t)5632 * 1024; S.first = R * F.G; S.nhalf = Lc;
                  pg8::gemm_phase<pg8::EpiSwigluQ, pg8::Sched, true, true, true, 1>(F.lds, F.tid, D / 2, D / 2, D / 2, S, E); }
            PHASE_END
            PHASE_BEGIN
                const int nb = *(const int*)(ws + WS_NBLK);
                const float* wam = (const float*)(ws + WS_CTL) + CW_WAMAX;
                pg8::EpiStoreQ E{(bf16_t*)(ws + WS_YM), 1.f / pow2_scale(wam[128])}; const int units = nb * 4, R = units / F.G, Lc = units - R * F.G; const bool hs = Lc > 0 && 2 * Lc <= F.G && R > 0;
                { pg8::Sched S; S.init(nb, D / 256, F.G, F.bx, ws + WS_HM, DFF / 2, ws + WS_MD, DFF / 2); S.blk_e = (const int*)(ws + WS_BLK_E); S.b_estride = (size_t)1024 * DFF; if (hs) S.lim = R * F.G;
                  pg8::gemm_phase<pg8::EpiStoreQ, pg8::Sched, true, true, false, 2>(F.lds, F.tid, DFF / 2, DFF / 2, DFF / 2, S, E); }
                if (hs) { pg8::Sched S; S.init(nb, D / 256, F.G, F.bx, ws + WS_HM, DFF / 2, ws + WS_MD, DFF / 2); S.blk_e = (const int*)(ws + WS_BLK_E); S.b_estride = (size_t)1024 * DFF; S.first = R * F.G; S.nhalf = Lc;
                  pg8::gemm_phase<pg8::EpiStoreQ, pg8::Sched, true, true, true, 2>(F.lds, F.tid, DFF / 2, DFF / 2, DFF / 2, S, E); }
            PHASE_END
            PHASE_BEGIN
                p_combine_final(F, A);
            PHASE_END
        }
        }
    { constexpr int l = 1;
        if (l == 1) {
            PHASE_BEGIN
                p_norm<24, true>(F, (const float*)(ws + WS_XB), A->in[1] + D, XN, A->in[2] + (size_t)D * NIN, NIN, 2560, 4624, A->in[3] + NIN, ZS, nullptr, nullptr);
            PHASE_END
        }
        PHASE_BEGIN
            pg8::Sched S; S.init(T / 256, 20, F.G, F.bx, XN, D, (bf16_t*)(ws + WS_WIN) + (size_t)l * 8192 * 1024, D);
            pg8::EpiInproj E{ZA, ZG, A->in[3] + l * NIN};
            pg8::gemm_phase<pg8::EpiInproj, pg8::Sched, true, true>(F.lds, F.tid, D, D, D, S, E);
        PHASE_END
        PHASE_BEGIN
            p_mixer_prep(F, A, l);
            REFRAME();
            { const Half H = make_half(F); for (int u = F.vcu + (F.wave >> 2) * F.G; u < 1024; u += 2 * F.G) gla_local_h(H, F, A, u, l); }
            REFRAME();
            { const Half H = make_half(F); for (int u = F.vcu + (F.wave >> 2) * F.G; u < 1024; u += 2 * F.G) mlstm_local_h(H, F, A, u, l); }
        PHASE_END
        PHASE_BEGIN
            p_mixer_scan(F);
            REFRAME();
            p_moba_select(F, l);
        PHASE_END
        PHASE_BEGIN
            { const Half H = make_half(F); for (int u = F.vcu + (F.wave >> 2) * F.G; u < 1024; u += 2 * F.G) gla_out_h(H, F, A, u, l); }
            REFRAME();
            { const Half H = make_half(F); for (int u = F.vcu + (F.wave >> 2) * F.G; u < 1024; u += 2 * F.G) mlstm_out_h(H, F, u); }
        PHASE_END
        PHASE_BEGIN
            p_moba_sparse(F, l);
        PHASE_END
        PHASE_BEGIN
            p_moba_combine(F);
            REFRAME();
            pg8::Sched S; S.init(T / 256, 12, F.G, F.bx, XN, D, (bf16_t*)(ws + WS_WIN) + (size_t)l * 8192 * 1024, D); S.pn0 = 20;
            pg8::EpiInproj E{ZA, ZG, A->in[3] + l * NIN};
            pg8::gemm_phase<pg8::EpiInproj, pg8::Sched, true, true>(F.lds, F.tid, D, D, D, S, E);
        PHASE_END
        PHASE_BEGIN
            pg8::Sched S; S.init(T / 256, 4, F.G, F.bx, Y012, 512, (bf16_t*)(ws + WS_WUP) + (size_t)l * 3072 * 512, 512); S.a_split_tiles = 4; S.a_split_bytes = (size_t)T * 512 * 2; S.branch3 = 1;
            pg8::EpiUpGate E{U, ZG};
            pg8::gemm_phase<pg8::EpiUpGate, pg8::Sched, true, true>(F.lds, F.tid, 512, 512, 512, S, E);
        PHASE_END
        PHASE_BEGIN
            pg8::Sched S; S.init(T / 256, D / 256, F.G, F.bx, U, D, (bf16_t*)(ws + WS_WO3) + (size_t)l * 1024 * 1024, D);
            if (l == 0) { pg8::EpiResidT<false, true> E{A->in[0], ws + WS_XB}; pg8::gemm_phase<pg8::EpiResidT<false, true>, pg8::Sched, true, true>(F.lds, F.tid, D, D, D, S, E); }
            else { pg8::EpiResidT<true, false> E{ws + WS_XB, F.X}; pg8::gemm_phase<pg8::EpiResidT<true, false>, pg8::Sched, true, true>(F.lds, F.tid, D, D, D, S, E); }
        PHASE_END
        if (l == 0) {
            PHASE_BEGIN
                p_norm<0, true>(F, (const float*)(ws + WS_XB), A->in[13], XN, nullptr, 0, 0, 0, nullptr, nullptr, nullptr, nullptr);
            PHASE_END
            PHASE_BEGIN
                pg8::EpiSwiglu E{HD}; const int units = (T / 256) * 22, R = units / F.G, Lc = units - R * F.G; const bool hs = Lc > 0 && 2 * Lc <= F.G && R > 0;
                { pg8::Sched S; S.init(T / 256, 5632 / 256, F.G, F.bx, XN, D, ws + WS_WFGU, D); if (hs) S.lim = R * F.G;
                  pg8::gemm_phase<pg8::EpiSwiglu, pg8::Sched, true, true>(F.lds, F.tid, D, D, D, S, E); }
                if (hs) { pg8::Sched S; S.init(T / 256, 5632 / 256, F.G, F.bx, XN, D, ws + WS_WFGU, D); S.first = R * F.G; S.nhalf = Lc;
                  pg8::gemm_phase<pg8::EpiSwiglu, pg8::Sched, true, true, true>(F.lds, F.tid, D, D, D, S, E); }
            PHASE_END
            PHASE_BEGIN
                pg8::Sched S; S.init(T / 256, D / 256, F.G, F.bx, HD, DFF, ws + WS_WFD, DFF);
                pg8::EpiResidT<true, true> E{ws + WS_XB, ws + WS_XB};
                pg8::gemm_phase<pg8::EpiResidT<true, true>, pg8::Sched, true, true>(F.lds, F.tid, DFF, DFF, DFF, S, E);
            PHASE_END
        } else {
            PHASE_BEGIN
                p_prep_moe_weights(F, A); __syncthreads();
                p_norm<8, false, true>(F, F.X, A->in[13] + D, (bf16_t*)(ws + WS_XN2), A->in[17], 8, 0, 0, A->in[18], nullptr, (int*)(ws + WS_TOPE), (float*)(ws + WS_TOPG));
            PHASE_END
            PHASE_BEGIN
                p_route_gather(F);
            PHASE_END
            PHASE_BEGIN
                const int nb = *(const int*)(ws + WS_NBLK);
                const float* wam = (const float*)(ws + WS_CTL) + CW_WAMAX;
                pg8::EpiSwigluQ E{(bf16_t*)(ws + WS_HM), (const float*)(ws + WS_RSG), 1.f / pow2_scale(wam[0]), 1.f / pow2_scale(wam[64])}; const int units = nb * 22, R = units / F.G, Lc = units - R * F.G; const bool hs = Lc > 0 && 2 * Lc <= F.G && R > 0;
                { pg8::Sched S; S.init(nb, 5632 / 256, F.G, F.bx, ws + WS_YM, D / 2, ws + WS_MGU, D / 2); S.blk_e = (const int*)(ws + WS_BLK_E); S.b_estride = (size_t)5632 * 1024; if (hs) S.lim = R * F.G;
                  pg8::gemm_phase<pg8::EpiSwigluQ, pg8::Sched, true, true, false, 1>(F.lds, F.tid, D / 2, D / 2, D / 2, S, E); }
                if (hs) { pg8::Sched S; S.init(nb, 5632 / 256, F.G, F.bx, ws + WS_YM, D / 2, ws + WS_MGU, D / 2); S.blk_e = (const int*)(ws + WS_BLK_E); S.b_estride = (size_t)5632 * 1024; S.first = R * F.G; S.nhalf = Lc;
                  pg8::gemm_phase<pg8::EpiSwigluQ, pg8::Sched, true, true, true, 1>(F.lds, F.tid, D / 2, D / 2, D / 2, S, E); }
            PHASE_END
            PHASE_BEGIN
                const int nb = *(const int*)(ws + WS_NBLK);
                const float* wam = (const float*)(ws + WS_CTL) + CW_WAMAX;
                pg8::EpiStoreQ E{(bf16_t*)(ws + WS_YM), 1.f / pow2_scale(wam[128])}; const int units = nb * 4, R = units / F.G, Lc = units - R * F.G; const bool hs = Lc > 0 && 2 * Lc <= F.G && R > 0;
                { pg8::Sched S; S.init(nb, D / 256, F.G, F.bx, ws + WS_HM, DFF / 2, ws + WS_MD, DFF / 2); S.blk_e = (const int*)(ws + WS_BLK_E); S.b_estride = (size_t)1024 * DFF; if (hs) S.lim = R * F.G;
                  pg8::gemm_phase<pg8::EpiStoreQ, pg8::Sched, true, true, false, 2>(F.lds, F.tid, DFF / 2, DFF / 2, DFF / 2, S, E); }
                if (hs) { pg8::Sched S; S.init(nb, D / 256, F.G, F.bx, ws + WS_HM, DFF / 2, ws + WS_MD, DFF / 2); S.blk_e = (const int*)(ws + WS_BLK_E); S.b_estride = (size_t)1024 * DFF; S.first = R * F.G; S.nhalf = Lc;
                  pg8::gemm_phase<pg8::EpiStoreQ, pg8::Sched, true, true, true, 2>(F.lds, F.tid, DFF / 2, DFF / 2, DFF / 2, S, E); }
            PHASE_END
            PHASE_BEGIN
                p_combine_final(F, A);
            PHASE_END
        }
        }
#undef PHASE_BEGIN
#undef PHASE_END
}

#ifndef MK_SPLIT
#define MK_SPLIT 0
#endif
extern "C" void kernel_launch(void* const* d_in, const int* in_sizes, int n_in, void* d_out, int out_size, void* d_ws, size_t ws_size, hipStream_t stream) {
    static int grid = 0;
    if (grid == 0) {
        if (n_in != 23 || out_size != T * D || ws_size < WS_END) { fprintf(stderr, "kernel_launch: unexpected shapes (n_in %d out %d ws %zu)\n", n_in, out_size, ws_size); grid = -1; return; }
        int dev = 0, cus = 0, per_cu = 0;
        if (hipGetDevice(&dev) != hipSuccess || hipDeviceGetAttribute(&cus, hipDeviceAttributeMultiprocessorCount, dev) != hipSuccess) { grid = -1; return; }
        if (hipFuncSetAttribute((const void*)fwd, hipFuncAttributeMaxDynamicSharedMemorySize, LDS_BYTES) != hipSuccess) { fprintf(stderr, "kernel_launch: hipFuncSetAttribute failed\n"); grid = -1; return; }
        if (hipOccupancyMaxActiveBlocksPerMultiprocessor(&per_cu, (const void*)fwd, NTHREADS, LDS_BYTES) != hipSuccess || per_cu < 1) fprintf(stderr, "kernel_launch: occupancy query reports %d\n", per_cu);
        (void)hipGetLastError();
        grid = cus;
    }
    if (grid < 0) return;
    (void)hipMemsetAsync((char*)d_ws + WS_CTL, 0, CTL_ZERO_BYTES, stream);
    Args a{};
    for (int i = 0; i < 23; ++i) a.in[i] = (const float*)d_in[i];
    a.out = (float*)d_out; a.ws = (unsigned char*)d_ws;
#if MK_SPLIT
    for (int p = 0; p < N_PHASES; ++p) { a.ph_lo = p; a.ph_hi = p + 1; hipLaunchKernelGGL(fwd, dim3(grid), dim3(NTHREADS), LDS_BYTES, stream, a); }
#else
    a.ph_lo = 0; a.ph_hi = N_PHASES;
    hipLaunchKernelGGL(fwd, dim3(grid), dim3(NTHREADS), LDS_BYTES, stream, a);
#endif
}
```

```cpp
#include <hip/hip_runtime.h>
#include <hip/hip_bf16.h>
#include <stdint.h>
#include <cstdio>
#include <cmath>

typedef unsigned short bf16_t;
#define DEV __device__ __forceinline__
#define LAS __attribute__((address_space(3)))
#define GAS __attribute__((address_space(1)))

constexpr int T = 16384, SEQ = 8192, D = 1024, NIN = 8216, DFF = 2816;
constexpr int ZA_LD = 5120, ZG_LD = 3072;
constexpr int ZA_MQ = 0, ZA_MK = 512, ZA_MV = 1024, ZA_GQ = 1536, ZA_GK = 1792, ZA_GV = 2048, ZA_GR = 2560, ZA_LQ = 3072, ZA_LK = 3584, ZA_LV = 4096, ZA_LO = 4608;
constexpr float EPS = 1e-6f;
constexpr int MOE_ROWS = 34816;
constexpr int NWAVES = 8, NTHREADS = 512;

constexpr size_t MiB = 1u << 20;
constexpr size_t WS_CTL = 0, CTL_ZERO_BYTES = 64 * 1024;
constexpr size_t WS_ROPE_COS = 1 * MiB, WS_ROPE_SIN = 1 * MiB + 256 * 1024, WS_KM = 1 * MiB + 512 * 1024, WS_DEN = 1 * MiB + 640 * 1024;
constexpr size_t WS_TOPE = 2 * MiB, WS_TOPG = 2 * MiB + 128 * 1024, WS_SLOT = 2 * MiB + 256 * 1024, WS_ROWS_TOK = 2 * MiB + 384 * 1024, WS_ROWS_G = 2 * MiB + 640 * 1024,
                 WS_BLK_E = 2 * MiB + 896 * 1024, WS_NBLK = 2 * MiB + 900 * 1024;
constexpr size_t WS_RS = 3 * MiB, WS_RSG = 3 * MiB + 256 * 1024;
constexpr size_t WS_ZS = 4 * MiB;
constexpr size_t WS_WIN = 6 * MiB;
constexpr size_t WS_WUP = 38 * MiB;
constexpr size_t WS_WO3 = 44 * MiB;
constexpr size_t WS_WFGU = 56 * MiB;
constexpr size_t WS_WFD = 67 * MiB;
constexpr size_t WS_XN = 73 * MiB;
constexpr size_t WS_ZG = 201 * MiB;
constexpr size_t WS_ZA = 201 * MiB;
constexpr size_t WS_U = 297 * MiB;
constexpr size_t WS_HD = 201 * MiB;
constexpr size_t WS_Y012 = 361 * MiB;
constexpr size_t WS_MGU = 6 * MiB;
constexpr size_t WS_MD = 94 * MiB;
constexpr size_t WS_XN2 = 138 * MiB;
constexpr size_t WS_HM = 170 * MiB;
constexpr size_t WS_YM = 264 * MiB;
constexpr size_t WS_CQK2 = 105 * MiB;
constexpr size_t WS_UG = 137 * MiB;
constexpr size_t WS_UG2 = 153 * MiB;
constexpr size_t WS_DEC = 185 * MiB;
constexpr size_t WS_NU = 185 * MiB + 256 * 1024;
constexpr size_t WS_BL = 185 * MiB + 768 * 1024, WS_AMAX = WS_BL + 4096, WS_MPREV = WS_AMAX + 4096;
constexpr size_t WS_XB = 409 * MiB;
constexpr size_t WS_END = 441 * MiB;
constexpr int CW_TMO = 0, CW_BAR = 4096, CW_MOECNT = 2048, CW_WAMAX = 1024;

constexpr int RING_BYTES = 131072, LDSCTL_OFF = RING_BYTES, MISC_OFF = LDSCTL_OFF + 320, LDS_BYTES = 147456;

DEV float bf2f(bf16_t v) { return __uint_as_float((unsigned)v << 16); }
typedef float f32x2c_t __attribute__((ext_vector_type(2))); typedef __bf16 bf16x2c_t __attribute__((ext_vector_type(2)));
DEV unsigned cvt2bf(float lo, float hi) { const f32x2c_t v = {lo, hi}; return __builtin_bit_cast(unsigned, __builtin_convertvector(v, bf16x2c_t)); }
DEV unsigned pk4_fp8(float a, float b, float c, float d) {
    a = __builtin_amdgcn_fmed3f(a, -448.f, 448.f); b = __builtin_amdgcn_fmed3f(b, -448.f, 448.f); c = __builtin_amdgcn_fmed3f(c, -448.f, 448.f); d = __builtin_amdgcn_fmed3f(d, -448.f, 448.f);
    int w = __builtin_amdgcn_cvt_pk_fp8_f32(a, b, 0, false); w = __builtin_amdgcn_cvt_pk_fp8_f32(c, d, w, true); return (unsigned)w; }
DEV float pow2_scale(float amax) { return amax > 0.f ? exp2f(floorf(__log2f(192.f / amax))) : 1.f; }
DEV bf16_t f2bf(float f) { return (bf16_t)(cvt2bf(f, 0.f) & 0xffffu); }
DEV float sigmoidf_(float x) { return __builtin_amdgcn_rcpf(1.f + __expf(-x)); }
DEV float siluf_(float x) { return x * sigmoidf_(x); }
DEV float logsigmoidf_(float x) { return fminf(x, 0.f) - 0.6931471805599453f * __log2f(1.f + __expf(-fabsf(x))); }
#define DPPF(old_, v_, ctrl_, rm_) __builtin_bit_cast(float, __builtin_amdgcn_update_dpp(__builtin_bit_cast(int, (float)(old_)), __builtin_bit_cast(int, (float)(v_)), (ctrl_), (rm_), 0xf, false))
DEV float scan_add(float v, int) {
    v += DPPF(0.f, v, 0x111, 0xf); v += DPPF(0.f, v, 0x112, 0xf); v += DPPF(0.f, v, 0x114, 0xf); v += DPPF(0.f, v, 0x118, 0xf);
    v += DPPF(0.f, v, 0x142, 0xa); v += DPPF(0.f, v, 0x143, 0xc); return v;
}
DEV float scan_max(float v, int) {
    const float ni = -INFINITY;
    v = fmaxf(v, DPPF(ni, v, 0x111, 0xf)); v = fmaxf(v, DPPF(ni, v, 0x112, 0xf)); v = fmaxf(v, DPPF(ni, v, 0x114, 0xf)); v = fmaxf(v, DPPF(ni, v, 0x118, 0xf));
    v = fmaxf(v, DPPF(ni, v, 0x142, 0xa)); v = fmaxf(v, DPPF(ni, v, 0x143, 0xc)); return v;
}
DEV float wave_sum(float v) { return __builtin_bit_cast(float, __builtin_amdgcn_readlane(__builtin_bit_cast(int, scan_add(v, 0)), 63)); }
DEV float wave_max(float v) { return __builtin_bit_cast(float, __builtin_amdgcn_readlane(__builtin_bit_cast(int, scan_max(v, 0)), 63)); }

namespace pg8 {
#define PG8_LAS __attribute__((address_space(3)))
typedef short bf16x8 __attribute__((ext_vector_type(8)));
typedef float f32x4 __attribute__((ext_vector_type(4)));
typedef unsigned u32x4 __attribute__((ext_vector_type(4)));
constexpr int BM = 256, BK = 64, HALF = 128, HTB = HALF * BK * 2, STAGE_BYTES = 8 * HTB, NXCD = 8, WGM = 8;
__host__ __device__ __forceinline__ int lds_byte(int r, int c) { const int st = (r >> 4) * 2 + (c >> 5), rr = r & 15, cc = c & 31, ob = rr * 64 + cc * 2; return st * 1024 + (ob ^ (((ob >> 9) & 1) << 5)); }
__host__ __device__ __forceinline__ void stage_rc(int b, int& R, int& C) { const int st = b / 1024, sb = b % 1024, swz = sb ^ (((sb >> 9) & 1) << 5); R = (st >> 1) * 16 + swz / 64; C = (st & 1) * 32 + (swz % 64) / 2; }
__host__ __device__ __forceinline__ int perm32(int rho) { const int n = rho >> 4, i = rho & 15; return 8 * (i >> 2) + 4 * n + (i & 3); }

struct Unit { int pm, pn; const char* a; const char* b; int kh, q, hm; };
struct Sched {
    int nM, nN, nwg, G, c, pn0, branch3, first, lim, nsplit, nhalf; unsigned kbytes;
    const char* A; size_t a_tile; int a_split_tiles; size_t a_split_bytes;
    const char* B; size_t b_tile; const int* blk_e; size_t b_estride;
    __device__ __forceinline__ void init(int nM_, int nN_, int G_, int c_, const void* A_, int lda, const void* B_, int ldb) {
        nM = nM_; nN = nN_; nwg = nM * nN; G = G_; c = c_; pn0 = 0; branch3 = 0; first = 0; lim = nM_ * nN_; nsplit = 0; nhalf = 0; kbytes = 0u; A = (const char*)A_; a_tile = (size_t)BM * lda * 2; a_split_tiles = 0; a_split_bytes = 0;
        B = (const char*)B_; b_tile = (size_t)BM * ldb * 2; blk_e = nullptr; b_estride = 0; }
    __device__ __forceinline__ bool next(int i, Unit& u) const {
        long L; u.kh = 0; u.q = 0; u.hm = 0;
        if (nhalf > 0) { if (i > 0 || c >= 2 * nhalf) return false; L = first + (c >> 1); u.hm = 1 + (c & 1); } else
        if (nsplit > 0) { if (i > 0 || c >= 2 * nsplit) return false; L = first + (c >> 1); u.kh = c & 1; u.q = c >> 1; }
        else { L = branch3 ? (long)c : (long)first + (long)i * G + c; if (L >= lim || (branch3 && i >= 3)) return false; }
        int wgid = (int)L; { const int q = nwg / NXCD, r = nwg % NXCD, xcd = wgid % NXCD, off = wgid / NXCD; wgid = (xcd < r ? xcd * (q + 1) : r * (q + 1) + (xcd - r) * q) + off; }
        const int nig = WGM * nN, gid = wgid / nig, fm = gid * WGM, gsz = (nM - fm) < WGM ? (nM - fm) : WGM;
        u.pm = fm + ((wgid % nig) % gsz); u.pn = pn0 + (wgid % nig) / gsz + (branch3 ? 4 * i : 0);
        u.a = A + (size_t)u.pm * a_tile + (a_split_tiles ? (size_t)(u.pn / a_split_tiles) * a_split_bytes : 0);
        u.b = B + (size_t)u.pn * b_tile + (blk_e ? (size_t)blk_e[u.pm] * b_estride : 0);
        if (u.kh) { u.a += kbytes; u.b += kbytes; }
        if (u.hm == 2) u.a += (a_tile >> 1);
        return true;
    }
    __device__ __forceinline__ void a_ready(const Unit&) const {}
    __device__ __forceinline__ void done(const Unit&) const {}
};

__device__ __forceinline__ unsigned cvt_pk_bf16(float lo, float hi) { unsigned r; asm volatile("v_cvt_pk_bf16_f32 %0, %1, %2" : "=v"(r) : "v"(lo), "v"(hi)); return r; }
__device__ __forceinline__ float fsig(float x) { return __builtin_amdgcn_rcpf(1.f + __expf(-x)); }
__device__ __forceinline__ f32x4 unpk_lo(unsigned a, unsigned b) { return (f32x4){__uint_as_float(a << 16), __uint_as_float(a & 0xffff0000u), __uint_as_float(b << 16), __uint_as_float(b & 0xffff0000u)}; }
__device__ __forceinline__ void st16_wt(unsigned char* wsb, const void* p, u32x4 v) {
    const __amdgpu_buffer_rsrc_t rs = __builtin_amdgcn_make_buffer_rsrc((void*)wsb, (short)0, 0x7ffffff0, 0x00020000);
    __builtin_amdgcn_raw_buffer_store_b128(v, rs, (int)((const unsigned char*)p - wsb), 0, 16); }
struct EpiInproj {
    static constexpr bool PERM = true, AFTER_DRAIN = false;
    bf16_t* ZA; bf16_t* ZG; const float* bias; unsigned char* wsb;
    __device__ __forceinline__ void operator()(const f32x4 (&acc)[2][2][4][2], const Unit& u, int wr, int wc, int fr, int fq) const {
        const int row0 = u.pm * BM + wr * 64 + fr, colt = u.pn * BM, shift = colt >= 4608 ? 24 : (colt >= 2560 ? 16 : 0), lc = wc * 32 + 8 * fq;
        bf16_t* base = colt < ZA_LD ? ZA : ZG; const int ld = colt < ZA_LD ? ZA_LD : ZG_LD, cb = colt < ZA_LD ? colt : colt - ZA_LD;
        f32x4 bv[2][2];
#pragma unroll
        for (int bj = 0; bj < 2; ++bj)
#pragma unroll
            for (int n = 0; n < 2; ++n) bv[bj][n] = *(const f32x4*)(bias + colt + shift + bj * HALF + lc + 4 * n);
#pragma unroll
        for (int ai = 0; ai < 2; ++ai)
#pragma unroll
            for (int m = 0; m < 4; ++m) { bf16_t* rowp = base + (size_t)(row0 + ai * HALF + m * 16) * ld + cb + lc;
#pragma unroll
                for (int bj = 0; bj < 2; ++bj) { const f32x4 v0 = acc[ai][bj][m][0] + bv[bj][0], v1 = acc[ai][bj][m][1] + bv[bj][1];
                    u32x4 w; w.x = cvt_pk_bf16(v0[0], v0[1]); w.y = cvt_pk_bf16(v0[2], v0[3]); w.z = cvt_pk_bf16(v1[0], v1[1]); w.w = cvt_pk_bf16(v1[2], v1[3]);
                    st16_wt(wsb, rowp + bj * HALF, w); } }
    }
};
struct EpiUpGate {
    static constexpr bool PERM = true, AFTER_DRAIN = false;
    bf16_t* M; const bf16_t* ZG;
    __device__ __forceinline__ void operator()(const f32x4 (&acc)[2][2][4][2], const Unit& u, int wr, int wc, int fr, int fq) const {
        const int row0 = u.pm * BM + wr * 64 + fr, gcol0 = u.pn * BM + wc * 32 + 8 * fq, mcol0 = (u.pn & 3) * BM + wc * 32 + 8 * fq; const bool first = (u.pn >> 2) == 0;
#pragma unroll
        for (int ai = 0; ai < 2; ++ai) { u32x4 gw[4][2], pw[4][2];
#pragma unroll
            for (int m = 0; m < 4; ++m)
#pragma unroll
                for (int bj = 0; bj < 2; ++bj) { gw[m][bj] = __builtin_nontemporal_load((const u32x4*)(ZG + (size_t)(row0 + ai * HALF + m * 16) * ZG_LD + gcol0 + bj * HALF));
                    if (!first) pw[m][bj] = *(const u32x4*)(M + (size_t)(row0 + ai * HALF + m * 16) * D + mcol0 + bj * HALF); }
            asm volatile("" ::: "memory");
#pragma unroll
            for (int m = 0; m < 4; ++m)
#pragma unroll
                for (int bj = 0; bj < 2; ++bj) { const f32x4 g0 = unpk_lo(gw[m][bj].x, gw[m][bj].y), g1 = unpk_lo(gw[m][bj].z, gw[m][bj].w); f32x4 v0 = acc[ai][bj][m][0], v1 = acc[ai][bj][m][1];
#pragma unroll
                    for (int j = 0; j < 4; ++j) { v0[j] *= fsig(g0[j]); v1[j] *= fsig(g1[j]); }
                    if (!first) { v0 += unpk_lo(pw[m][bj].x, pw[m][bj].y); v1 += unpk_lo(pw[m][bj].z, pw[m][bj].w); }
                    u32x4 w; w.x = cvt_pk_bf16(v0[0], v0[1]); w.y = cvt_pk_bf16(v0[2], v0[3]); w.z = cvt_pk_bf16(v1[0], v1[1]); w.w = cvt_pk_bf16(v1[2], v1[3]);
                    *(u32x4*)(M + (size_t)(row0 + ai * HALF + m * 16) * D + mcol0 + bj * HALF) = w; }
            asm volatile("" ::: "memory"); }
    }
};
template <bool BASE_BF16, bool OUT_BF16>
struct EpiResidT {
    static constexpr bool PERM = true, AFTER_DRAIN = false;
    const void* base; void* out;
    __device__ __forceinline__ void operator()(const f32x4 (&acc)[2][2][4][2], const Unit& u, int wr, int wc, int fr, int fq) const {
        const int row0 = u.pm * BM + wr * 64 + fr, col0 = u.pn * BM + wc * 32 + 8 * fq;
#pragma unroll
        for (int ai = 0; ai < 2; ++ai) { f32x4 b[4][2][2];
#pragma unroll
            for (int m = 0; m < 4; ++m)
#pragma unroll
                for (int bj = 0; bj < 2; ++bj) { const size_t o2 = (size_t)(row0 + ai * HALF + m * 16) * D + col0 + bj * HALF;
                    if (BASE_BF16) { const u32x4 w = *(const u32x4*)((const bf16_t*)base + o2); b[m][bj][0] = unpk_lo(w.x, w.y); b[m][bj][1] = unpk_lo(w.z, w.w); }
                    else { b[m][bj][0] = __builtin_nontemporal_load((const f32x4*)((const float*)base + o2)); b[m][bj][1] = __builtin_nontemporal_load((const f32x4*)((const float*)base + o2 + 4)); } }
            asm volatile("" ::: "memory");
#pragma unroll
            for (int m = 0; m < 4; ++m)
#pragma unroll
                for (int bj = 0; bj < 2; ++bj) { const size_t o2 = (size_t)(row0 + ai * HALF + m * 16) * D + col0 + bj * HALF; const f32x4 v0 = b[m][bj][0] + acc[ai][bj][m][0], v1 = b[m][bj][1] + acc[ai][bj][m][1];
                    if (OUT_BF16) { u32x4 w; w.x = cvt_pk_bf16(v0[0], v0[1]); w.y = cvt_pk_bf16(v0[2], v0[3]); w.z = cvt_pk_bf16(v1[0], v1[1]); w.w = cvt_pk_bf16(v1[2], v1[3]); *(u32x4*)((bf16_t*)out + o2) = w; }
                    else { *(f32x4*)((float*)out + o2) = v0; *(f32x4*)((float*)out + o2 + 4) = v1; } }
            asm volatile("" ::: "memory"); }
    }
};
struct EpiSwiglu {
    static constexpr bool PERM = true, AFTER_DRAIN = false;
    bf16_t* H;
    __device__ __forceinline__ void operator()(const f32x4 (&acc)[2][2][4][2], const Unit& u, int wr, int wc, int fr, int fq) const {
        const int row0 = u.pm * BM + (u.hm == 2 ? HALF : 0) + wr * 64 + fr, col0 = u.pn * HALF + wc * 32 + 8 * fq;
#pragma unroll
        for (int ai = 0; ai < 2; ++ai) if (ai == 0 || u.hm == 0)
#pragma unroll
            for (int m = 0; m < 4; ++m) { f32x4 v0, v1;
#pragma unroll
                for (int j = 0; j < 4; ++j) { const float a0 = acc[ai][0][m][0][j], a1 = acc[ai][0][m][1][j]; v0[j] = a0 * fsig(a0) * acc[ai][1][m][0][j]; v1[j] = a1 * fsig(a1) * acc[ai][1][m][1][j]; }
                u32x4 w; w.x = cvt_pk_bf16(v0[0], v0[1]); w.y = cvt_pk_bf16(v0[2], v0[3]); w.z = cvt_pk_bf16(v1[0], v1[1]); w.w = cvt_pk_bf16(v1[2], v1[3]);
                *(u32x4*)(H + (size_t)(row0 + ai * HALF + m * 16) * DFF + col0) = w; }
    }
};
struct EpiSwigluQ {
    static constexpr bool PERM = true, AFTER_DRAIN = false;
    bf16_t* H; const float* rs; float cg, cu;
    __device__ __forceinline__ void operator()(const f32x4 (&acc)[2][2][4][2], const Unit& u, int wr, int wc, int fr, int fq) const {
        const int row0 = u.pm * BM + (u.hm == 2 ? HALF : 0) + wr * 64 + fr, col0 = u.pn * HALF + wc * 32 + 8 * fq;
        float rr[2][4];
#pragma unroll
        for (int ai = 0; ai < 2; ++ai)
#pragma unroll
            for (int m = 0; m < 4; ++m) rr[ai][m] = (ai == 0 || u.hm == 0) ? rs[row0 + ai * HALF + m * 16] : 0.f;
        asm volatile("" ::: "memory");
#pragma unroll
        for (int ai = 0; ai < 2; ++ai) if (ai == 0 || u.hm == 0)
#pragma unroll
            for (int m = 0; m < 4; ++m) { f32x4 v0, v1; const float r_ = rr[ai][m], sg = r_ * cg, su = r_ * cu;
#pragma unroll
                for (int j = 0; j < 4; ++j) { const float a0 = acc[ai][0][m][0][j] * sg, a1 = acc[ai][0][m][1][j] * sg; v0[j] = a0 * fsig(a0) * (acc[ai][1][m][0][j] * su); v1[j] = a1 * fsig(a1) * (acc[ai][1][m][1][j] * su); }
                int w0 = __builtin_amdgcn_cvt_pk_bf8_f32(v0[0], v0[1], 0, false); w0 = __builtin_amdgcn_cvt_pk_bf8_f32(v0[2], v0[3], w0, true);
                int w1 = __builtin_amdgcn_cvt_pk_bf8_f32(v1[0], v1[1], 0, false); w1 = __builtin_amdgcn_cvt_pk_bf8_f32(v1[2], v1[3], w1, true);
                uint2 w; w.x = (unsigned)w0; w.y = (unsigned)w1; *(uint2*)((unsigned char*)H + (size_t)(row0 + ai * HALF + m * 16) * DFF + col0) = w; }
    }
};
struct EpiStoreQ {
    static constexpr bool PERM = true, AFTER_DRAIN = false;
    bf16_t* O; float cd;
    __device__ __forceinline__ void operator()(const f32x4 (&acc)[2][2][4][2], const Unit& u, int wr, int wc, int fr, int fq) const {
        const int row0 = u.pm * BM + (u.hm == 2 ? HALF : 0) + wr * 64 + fr, col0 = u.pn * BM + wc * 32 + 8 * fq;
#pragma unroll
        for (int ai = 0; ai < 2; ++ai) if (ai == 0 || u.hm == 0)
#pragma unroll
            for (int m = 0; m < 4; ++m)
#pragma unroll
                for (int bj = 0; bj < 2; ++bj) { const f32x4 v0 = acc[ai][bj][m][0] * cd, v1 = acc[ai][bj][m][1] * cd;
                    u32x4 w; w.x = cvt_pk_bf16(v0[0], v0[1]); w.y = cvt_pk_bf16(v0[2], v0[3]); w.z = cvt_pk_bf16(v1[0], v1[1]); w.w = cvt_pk_bf16(v1[2], v1[3]);
                    *(u32x4*)(O + (size_t)(row0 + ai * HALF + m * 16) * D + col0 + bj * HALF) = w; }
    }
};
struct EpiStore {
    static constexpr bool PERM = true, AFTER_DRAIN = false;
    bf16_t* O; bf16_t* OB;
    __device__ __forceinline__ void operator()(const f32x4 (&acc)[2][2][4][2], const Unit& u, int wr, int wc, int fr, int fq) const {
        if (u.kh) { bf16_t* T = OB + (size_t)u.q * 65536; const int r0 = wr * 64 + fr, c0 = wc * 32 + 8 * fq;
#pragma unroll
            for (int ai = 0; ai < 2; ++ai)
#pragma unroll
                for (int m = 0; m < 4; ++m)
#pragma unroll
                    for (int bj = 0; bj < 2; ++bj) { const f32x4 v0 = acc[ai][bj][m][0], v1 = acc[ai][bj][m][1];
                        u32x4 w; w.x = cvt_pk_bf16(v0[0], v0[1]); w.y = cvt_pk_bf16(v0[2], v0[3]); w.z = cvt_pk_bf16(v1[0], v1[1]); w.w = cvt_pk_bf16(v1[2], v1[3]);
                        *(u32x4*)(T + (size_t)(r0 + ai * HALF + m * 16) * 256 + c0 + bj * HALF) = w; }
            return; }
        const int row0 = u.pm * BM + wr * 64 + fr, col0 = u.pn * BM + wc * 32 + 8 * fq;
#pragma unroll
        for (int ai = 0; ai < 2; ++ai)
#pragma unroll
            for (int m = 0; m < 4; ++m)
#pragma unroll
                for (int bj = 0; bj < 2; ++bj) { const f32x4 v0 = acc[ai][bj][m][0], v1 = acc[ai][bj][m][1];
                    u32x4 w; w.x = cvt_pk_bf16(v0[0], v0[1]); w.y = cvt_pk_bf16(v0[2], v0[3]); w.z = cvt_pk_bf16(v1[0], v1[1]); w.w = cvt_pk_bf16(v1[2], v1[3]);
                    *(u32x4*)(O + (size_t)(row0 + ai * HALF + m * 16) * D + col0 + bj * HALF) = w; }
    }
};

typedef int v8i_t __attribute__((ext_vector_type(8)));
typedef int v4i_t __attribute__((ext_vector_type(4)));
__device__ __forceinline__ v8i_t cat8(bf16x8 a, bf16x8 b) { const v4i_t x = __builtin_bit_cast(v4i_t, a), y = __builtin_bit_cast(v4i_t, b); return __builtin_shufflevector(x, y, 0, 1, 2, 3, 4, 5, 6, 7); }
template <int F8> __device__ __forceinline__ void mfma_q8(f32x4& c, const v8i_t a, const v8i_t b) {
    if constexpr (F8 == 2) asm volatile("v_mfma_f32_16x16x128_f8f6f4 %0, %1, %2, %0 blgp:1" : "+v"(c) : "v"(a), "v"(b));
    else asm volatile("v_mfma_f32_16x16x128_f8f6f4 %0, %1, %2, %0" : "+v"(c) : "v"(a), "v"(b)); }
template <class Epi, class Sched, bool ALIGN_EPI = false, bool SP2 = false, bool HALFM = false, int F8 = 0>
__device__ __forceinline__ void gemm_phase(PG8_LAS unsigned char* lds, const int tid, const int lda, const int ldb, const int K, const Sched& S, const Epi& E) {
    const int wid = __builtin_amdgcn_readfirstlane(tid >> 6), lane = tid & 63, wr = wid >> 2, wc = wid & 3, fr = lane & 15, fq = lane >> 4;
    const int nt = K / BK;
    unsigned voffA[2], voffB[2];
#pragma unroll
    for (int i = 0; i < 2; ++i) { int R, C; stage_rc(tid * 16 + i * 8192, R, C); const int Rb = Epi::PERM ? ((R & ~31) + perm32(R & 31)) : R;
        voffA[i] = (unsigned)(R * lda + C) * 2u; voffB[i] = (unsigned)(Rb * ldb + C) * 2u; }
    const size_t kstep = (size_t)(BK * 2);
    const size_t hstepA = (size_t)HALF * lda * 2, hstepB = (size_t)HALF * ldb * 2;
    const unsigned ldsw = (unsigned)wid * 1024u;
    const int aoff = lds_byte(wr * 64 + fr, fq * 8), boff = lds_byte(wc * 32 + fr, fq * 8);
#define PG8_SA(b, h) (((b) * 2 + (h)) * HTB)
#define PG8_SB(b, h) ((4 + (b) * 2 + (h)) * HTB)
#define PG8_STAGE(bufoff, gbase, voff) do { _Pragma("unroll") for (int _i = 0; _i < 2; ++_i) \
        __builtin_amdgcn_global_load_lds((const unsigned*)((const char*)(gbase) + (voff)[_i]), (PG8_LAS unsigned*)(lds + (bufoff) + ldsw + _i * 8192), 16, 0, 0); } while (0)
#define PG8_LDA(dst, b, h) do { _Pragma("unroll") for (int m = 0; m < 4; ++m) _Pragma("unroll") for (int k = 0; k < 2; ++k) dst[m][k] = *(const PG8_LAS bf16x8*)(lds + PG8_SA(b, h) + aoff + m * 2048 + k * 1024); } while (0)
#define PG8_LDB(dst, b, h) do { _Pragma("unroll") for (int n = 0; n < 2; ++n) _Pragma("unroll") for (int k = 0; k < 2; ++k) dst[n][k] = *(const PG8_LAS bf16x8*)(lds + PG8_SB(b, h) + boff + n * 2048 + k * 1024); } while (0)
#define PG8_MMA(ai, bj, At, Bt) do { __builtin_amdgcn_s_setprio(1); _Pragma("unroll") for (int m = 0; m < 4; ++m) _Pragma("unroll") for (int n = 0; n < 2; ++n) { \
        if constexpr (F8 != 0) mfma_q8<F8>(acc[ai][bj][m][n], cat8(Bt[n][0], Bt[n][1]), cat8(At[m][0], At[m][1])); \
        else { _Pragma("unroll") for (int k = 0; k < 2; ++k) acc[ai][bj][m][n] = __builtin_amdgcn_mfma_f32_16x16x32_bf16(Bt[n][k], At[m][k], acc[ai][bj][m][n], 0, 0, 0); } } __builtin_amdgcn_s_setprio(0); } while (0)
#define PG8_WAIT_V(n) asm volatile("s_waitcnt vmcnt(" #n ")" ::: "memory")
#define PG8_WAIT_L(n) asm volatile("s_waitcnt lgkmcnt(" #n ")" ::: "memory")
#define PG8_BAR __builtin_amdgcn_s_barrier()
#define PG8_SCHED __builtin_amdgcn_sched_barrier(0)
    Unit cur, nxt; int ui = 0;
    if (!S.next(0, cur)) return;
    f32x4 acc[2][2][4][2];
#pragma unroll
    for (int a = 0; a < 2; ++a)
#pragma unroll
        for (int b = 0; b < 2; ++b)
#pragma unroll
            for (int m = 0; m < 4; ++m)
#pragma unroll
                for (int n = 0; n < 2; ++n) acc[a][b][m][n] = (f32x4){0.f, 0.f, 0.f, 0.f};
    bf16x8 At[4][2], B0[2][2], B1[2][2];
    const char* cA = cur.a; const char* cB = cur.b;
    S.a_ready(cur);
    if constexpr (SP2) {
        PG8_STAGE(PG8_SB(0, 0), cB, voffB); PG8_STAGE(PG8_SB(0, 1), cB + hstepB, voffB); PG8_STAGE(PG8_SA(0, 0), cA, voffA); PG8_STAGE(PG8_SA(0, 1), cA + hstepA, voffA);
        if (wr == 1) PG8_BAR;
        PG8_WAIT_V(2); PG8_BAR;
        PG8_STAGE(PG8_SB(1, 0), cB + kstep, voffB); PG8_STAGE(PG8_SA(1, 0), cA + kstep, voffA); PG8_STAGE(PG8_SB(1, 1), cB + hstepB + kstep, voffB);
        PG8_WAIT_V(6); PG8_BAR;
    } else {
        PG8_STAGE(PG8_SB(0, 0), cB, voffB); PG8_STAGE(PG8_SA(0, 0), cA, voffA); PG8_STAGE(PG8_SB(0, 1), cB + hstepB, voffB); PG8_STAGE(PG8_SA(0, 1), cA + hstepA, voffA);
        if (wr == 1) PG8_BAR;
        PG8_WAIT_V(4); PG8_BAR;
        PG8_STAGE(PG8_SB(1, 0), cB + kstep, voffB); PG8_STAGE(PG8_SA(1, 0), cA + kstep, voffA); PG8_STAGE(PG8_SB(1, 1), cB + hstepB + kstep, voffB);
        PG8_WAIT_V(6); PG8_BAR;
    }
    for (;;) {
        const bool has_next = S.next(ui + 1, nxt);
        const char* nA = has_next ? nxt.a : cA; const char* nB = has_next ? nxt.b : cB;
        for (int t = 0; t < nt; t += 2) {
            const bool last = (t == nt - 2);
            const char* a1 = cA + (size_t)(t + 1) * kstep;
            const char* a2 = last ? nA : cA + (size_t)(t + 2) * kstep; const char* b2 = last ? nB : cB + (size_t)(t + 2) * kstep;
            const char* a3 = a2 + kstep; const char* b3 = b2 + kstep;
            if (last && has_next) S.a_ready(nxt);
            if constexpr (SP2) {
            PG8_LDB(B0, 0, 0); PG8_LDB(B1, 0, 1); PG8_SCHED; PG8_LDA(At, 0, 0); PG8_STAGE(PG8_SA(1, 1), a1 + hstepA, voffA);
            PG8_WAIT_V(8); PG8_WAIT_L(0); PG8_BAR; PG8_MMA(0, 0, At, B0); PG8_MMA(0, 1, At, B1); PG8_BAR; PG8_SCHED;
            if (!HALFM) PG8_LDA(At, 0, 1); PG8_STAGE(PG8_SB(0, 0), b2, voffB); PG8_STAGE(PG8_SB(0, 1), b2 + hstepB, voffB); PG8_STAGE(PG8_SA(0, 0), a2, voffA);
            PG8_WAIT_V(8); PG8_WAIT_L(0); PG8_BAR; if (!HALFM) { PG8_MMA(1, 0, At, B0); PG8_MMA(1, 1, At, B1); } PG8_BAR; PG8_SCHED;
            PG8_LDB(B0, 1, 0); PG8_LDB(B1, 1, 1); PG8_SCHED; PG8_LDA(At, 1, 0); PG8_STAGE(PG8_SA(0, 1), a2 + hstepA, voffA);
            PG8_WAIT_V(8); PG8_WAIT_L(0); PG8_BAR; PG8_MMA(0, 0, At, B0); PG8_MMA(0, 1, At, B1); PG8_BAR; PG8_SCHED;
            if (!HALFM) PG8_LDA(At, 1, 1); PG8_STAGE(PG8_SB(1, 0), b3, voffB); PG8_STAGE(PG8_SB(1, 1), b3 + hstepB, voffB); PG8_STAGE(PG8_SA(1, 0), a3, voffA);
            PG8_WAIT_V(8); PG8_WAIT_L(0); PG8_BAR; if (!HALFM) { PG8_MMA(1, 0, At, B0); PG8_MMA(1, 1, At, B1); } PG8_BAR; PG8_SCHED;
            } else {
            PG8_LDB(B0, 0, 0); PG8_SCHED; PG8_LDA(At, 0, 0); PG8_STAGE(PG8_SA(1, 1), a1 + hstepA, voffA);
            PG8_WAIT_L(8); PG8_BAR; PG8_WAIT_L(0); PG8_MMA(0, 0, At, B0); PG8_BAR; PG8_SCHED;
            PG8_LDB(B1, 0, 1); PG8_STAGE(PG8_SB(0, 0), b2, voffB);
            PG8_BAR; PG8_WAIT_L(0); PG8_MMA(0, 1, At, B1); PG8_BAR;
            PG8_LDA(At, 0, 1); PG8_STAGE(PG8_SA(0, 0), a2, voffA);
            PG8_BAR; PG8_WAIT_L(0); PG8_MMA(1, 0, At, B0); PG8_BAR; PG8_SCHED;
            PG8_STAGE(PG8_SB(0, 1), b2 + hstepB, voffB);
            PG8_WAIT_V(6); PG8_BAR; PG8_MMA(1, 1, At, B1); PG8_BAR;
            PG8_LDB(B0, 1, 0); PG8_SCHED; PG8_LDA(At, 1, 0); PG8_STAGE(PG8_SA(0, 1), a2 + hstepA, voffA);
            PG8_WAIT_L(8); PG8_BAR; PG8_WAIT_L(0); PG8_MMA(0, 0, At, B0); PG8_BAR; PG8_SCHED;
            PG8_LDB(B1, 1, 1); PG8_STAGE(PG8_SB(1, 0), b3, voffB);
            PG8_BAR; PG8_WAIT_L(0); PG8_MMA(0, 1, At, B1); PG8_BAR;
            PG8_LDA(At, 1, 1); PG8_STAGE(PG8_SA(1, 0), a3, voffA);
            PG8_BAR; PG8_WAIT_L(0); PG8_MMA(1, 0, At, B0); PG8_BAR; PG8_SCHED;
            PG8_STAGE(PG8_SB(1, 1), b3 + hstepB, voffB);
            PG8_WAIT_V(6); PG8_BAR; PG8_MMA(1, 1, At, B1); PG8_BAR;
            }
        }
        if constexpr (ALIGN_EPI) { if (wr == 0) PG8_BAR; }
        if constexpr (F8 != 0) { asm volatile("s_nop 15\n\ts_nop 15\n\ts_nop 15" ::: "memory"); __builtin_amdgcn_sched_barrier(0); }
        if constexpr (!Epi::AFTER_DRAIN) { E(acc, cur, wr, wc, fr, fq); S.done(cur); }
        if (!has_next) break;
#pragma unroll
        for (int a = 0; a < 2; ++a)
#pragma unroll
            for (int b = 0; b < 2; ++b)
#pragma unroll
                for (int m = 0; m < 4; ++m)
#pragma unroll
                    for (int n = 0; n < 2; ++n) acc[a][b][m][n] = (f32x4){0.f, 0.f, 0.f, 0.f};
        cur = nxt; cA = nA; cB = nB; ++ui;
        if constexpr (ALIGN_EPI) { if (wr == 1) PG8_BAR; }
    }
    PG8_WAIT_V(0);
    if constexpr (!ALIGN_EPI) { if (wr == 0) PG8_BAR; }
    PG8_BAR;
    if constexpr (Epi::AFTER_DRAIN) { E.fused(acc, cur, wr, wc, fr, fq, lds, wid, lane); S.done(cur); }
#undef PG8_SA
#undef PG8_SB
#undef PG8_STAGE
#undef PG8_LDA
#undef PG8_LDB
#undef PG8_MMA
#undef PG8_WAIT_V
#undef PG8_WAIT_L
#undef PG8_BAR
#undef PG8_SCHED
}
}

#define XB_TMO      128
#define XB_XCNT(j)  (256  + 64 * (j))
#define XB_XSUB(j)  (1280 + 64 * (j))
#define XB_XGEN(j)  (2304 + 64 * (j))
#define XB_TOP      3328
#define XB_TOPGEN   3392
#define XCD_BAR_WORDS 3456
#define XB_SPIN_CAP (1u << 24)

__device__ __forceinline__ unsigned xb_ld(unsigned* p)              { return __hip_atomic_load(p, __ATOMIC_RELAXED, __HIP_MEMORY_SCOPE_AGENT); }
__device__ __forceinline__ unsigned xb_add(unsigned* p, unsigned v) { return __hip_atomic_fetch_add(p, v, __ATOMIC_RELAXED, __HIP_MEMORY_SCOPE_AGENT); }
__device__ __forceinline__ unsigned xb_xcc_id() { return (unsigned)__builtin_amdgcn_s_getreg((3 << 11) | 20) & 0xFu; }
#define XB_SPIN(cond, bar) do { unsigned _sp = 0; while (cond) { __builtin_amdgcn_s_sleep(1); \
    if ((++_sp & 255u) == 0u) { if (xb_ld(&(bar)[XB_TMO])) break; if (_sp > XB_SPIN_CAP) { atomicAdd(&(bar)[XB_TMO], 1u); break; } } } } while (0)

struct XcdBarrier {
    unsigned* bar; unsigned x;
    volatile LAS unsigned* st;
};

__device__ __forceinline__ XcdBarrier xcd_barrier_post(unsigned* bar, volatile LAS unsigned* st) {
    XcdBarrier b; b.bar = bar; b.x = xb_xcc_id(); b.st = st;
    if (threadIdx.x == 0) (void)xb_add(&bar[XB_XCNT(b.x)], 1u);
    return b;
}
__device__ __forceinline__ void xcd_barrier_complete(unsigned* bar, unsigned x, unsigned& nloc, unsigned& nx) {
    const unsigned G = gridDim.x * gridDim.y * gridDim.z;
    unsigned sum, cnt, mine, sp = 0u;
    for (;;) {
        sum = 0u; cnt = 0u; mine = 0u;
#pragma unroll
        for (unsigned j = 0; j < 16; ++j) { const unsigned c = xb_ld(&bar[XB_XCNT(j)]); sum += c; cnt += (c > 0u) ? 1u : 0u; mine = (j == x) ? c : mine; }
        if (sum == G) break;
        __builtin_amdgcn_s_sleep(1);
        if ((++sp & 255u) == 0u) { if (xb_ld(&bar[XB_TMO])) break; if (sp > XB_SPIN_CAP) { atomicAdd(&bar[XB_TMO], 1u); break; } }
    }
    nloc = mine > 0u ? mine : 1u; nx = cnt > 0u ? cnt : 1u;
}

__device__ __forceinline__ void xcd_barrier(const XcdBarrier& b) {
    asm volatile("s_waitcnt vmcnt(0)" ::: "memory");
    __syncthreads();
    if (threadIdx.x == 0) {
        unsigned* bar = b.bar;
        __builtin_amdgcn_s_waitcnt(0);
        unsigned nloc = b.st[0], nx = b.st[1];
        if (nloc == 0u) { xcd_barrier_complete(bar, b.x, nloc, nx); b.st[0] = nloc; b.st[1] = nx; }
        const unsigned old = xb_add(&bar[XB_XSUB(b.x)], 1u);
        const unsigned gen = old / nloc;
        if (old + 1u == (gen + 1u) * nloc) {
            __builtin_amdgcn_fence(__ATOMIC_RELEASE, "agent");
            asm volatile("s_waitcnt vmcnt(0)" ::: "memory");
            const unsigned og = xb_add(&bar[XB_TOP], 1u);
            const unsigned tg = og / nx;
            if (og + 1u == (tg + 1u) * nx) xb_add(&bar[XB_TOPGEN], 1u);
            else XB_SPIN(xb_ld(&bar[XB_TOPGEN]) == tg, bar);
            __builtin_amdgcn_fence(__ATOMIC_ACQUIRE, "agent");
            xb_add(&bar[XB_XGEN(b.x)], 1u);
            asm volatile("s_waitcnt vmcnt(0)" ::: "memory");
        } else {
            XB_SPIN(xb_ld(&bar[XB_XGEN(b.x)]) == gen, bar);
            __builtin_amdgcn_fence(__ATOMIC_ACQUIRE, "agent");
            asm volatile("s_waitcnt vmcnt(0)" ::: "memory");
        }
    }
    __syncthreads();
}
typedef GAS unsigned gu32;
#define RLX_AGENT __ATOMIC_RELAXED, __HIP_MEMORY_SCOPE_AGENT
#define LDS_WAIT() asm volatile("s_waitcnt lgkmcnt(0)" ::: "memory")
typedef float f32x4 __attribute__((ext_vector_type(4)));
typedef unsigned v4u __attribute__((ext_vector_type(4)));

struct Frame {
    LAS unsigned char* lds; unsigned char* ldsg;
    int tid, lane, wave, vcu, G, gw, NGW, bx;
    float* X; unsigned char* ws;
};
typedef short bf16x8 __attribute__((ext_vector_type(8)));
typedef short v4i16_t __attribute__((ext_vector_type(4)));
typedef float f32x16 __attribute__((ext_vector_type(16)));
__host__ __device__ __forceinline__ void unit_tile(int L, int nM, int nN, int& pm, int& pn) {
    const int nwg = nM * nN; int wgid = L; { const int q = nwg / 8, r = nwg % 8, xcd = wgid % 8, off = wgid / 8; wgid = (xcd < r ? xcd * (q + 1) : r * (q + 1) + (xcd - r) * q) + off; }
    const int nig = 8 * nN, gid = wgid / nig, fm = gid * 8, gsz = (nM - fm) < 8 ? (nM - fm) : 8; pm = fm + ((wgid % nig) % gsz); pn = (wgid % nig) / gsz;
}
DEV int crow(int reg, int hh) { return (reg & 3) + 8 * (reg >> 2) + 4 * hh; }
#define MFMA32(a, b, c) __builtin_amdgcn_mfma_f32_32x32x16_bf16((a), (b), (c), 0, 0, 0)
struct Args { const float* in[23]; float* out; unsigned char* ws; int ph_lo, ph_hi; };
typedef const __attribute__((address_space(4))) Args* CArgs;
DEV unsigned pk2(float lo, float hi) { return cvt2bf(lo, hi); }

DEV void unpack8(const v4u u, float (&f)[8]) { f[0] = __uint_as_float(u.x << 16); f[1] = __uint_as_float(u.x & 0xffff0000u); f[2] = __uint_as_float(u.y << 16); f[3] = __uint_as_float(u.y & 0xffff0000u);
    f[4] = __uint_as_float(u.z << 16); f[5] = __uint_as_float(u.z & 0xffff0000u); f[6] = __uint_as_float(u.w << 16); f[7] = __uint_as_float(u.w & 0xffff0000u); }
DEV v4u pack8(const float (&f)[8]) { v4u u; u.x = pk2(f[0], f[1]); u.y = pk2(f[2], f[3]); u.z = pk2(f[4], f[5]); u.w = pk2(f[6], f[7]); return u; }

struct TrJob { const float* src; int ldsrc, K, N; bf16_t* dst; int lddst, row_off, k_off, mode; float q8; };
DEV void tr_item(const TrJob& j, LAS float* scr, int item, int lane) {
    const int nblk = j.N / 32, kb = item / nblk, nb = item % nblk, k0 = 64 * kb, n0 = 32 * nb;
    { const float* p_ = j.src + (size_t)(k0 + (lane >> 3)) * j.ldsrc + n0 + 4 * (lane & 7); f32x4 v_[8];
#pragma unroll
      for (int i = 0; i < 8; ++i) v_[i] = __builtin_nontemporal_load((const f32x4*)(p_ + (size_t)(8 * i) * j.ldsrc));
#pragma unroll
      for (int i = 0; i < 8; ++i)
#pragma unroll
          for (int e = 0; e < 4; ++e) scr[(8 * i + (lane >> 3)) * 33 + 4 * (lane & 7) + e] = v_[i][e]; }
    LDS_WAIT(); asm volatile("" ::: "memory");
    const int c = lane & 7;
    const int rbase = j.row_off + (j.mode ? (((n0 >> 7) << 8) + (n0 & 127)) : n0);
#pragma unroll
    for (int jj = 0; jj < 4; ++jj) { const int n = (lane >> 3) + 8 * jj; const LAS float* s = scr + (8 * c) * 33 + n;
        if (j.q8 != 0.f) { const float q = j.q8; uint2 o; o.x = pk4_fp8(s[0 * 33] * q, s[1 * 33] * q, s[2 * 33] * q, s[3 * 33] * q); o.y = pk4_fp8(s[4 * 33] * q, s[5 * 33] * q, s[6 * 33] * q, s[7 * 33] * q);
            *(uint2*)((unsigned char*)j.dst + (size_t)(rbase + n) * j.lddst + j.k_off + k0 + 8 * c) = o; continue; }
        v4u o; o.x = pk2(s[0 * 33], s[1 * 33]); o.y = pk2(s[2 * 33], s[3 * 33]); o.z = pk2(s[4 * 33], s[5 * 33]); o.w = pk2(s[6 * 33], s[7 * 33]);
        *(v4u*)(j.dst + (size_t)(rbase + n) * j.lddst + j.k_off + k0 + 8 * c) = o; }
    LDS_WAIT(); asm volatile("" ::: "memory");
}
DEV void tr_run(Frame& F, const TrJob& j, int& base, int& nxt, int stride = 0) {
    const int items = (j.K / 64) * (j.N / 32); LAS float* scr = (LAS float*)(F.lds + F.wave * 16384); if (stride == 0) stride = F.NGW;
    while (nxt < base + items) { tr_item(j, scr, nxt - base, F.lane); nxt += stride; }
    base += items;
}
DEV void p_prep_small_weights(Frame& F, CArgs A, int part) {
    int base = 0, nxt = F.gw;
    { const int l = part;
        const float* wl = A->in[2] + (size_t)l * D * NIN; bf16_t* WinT = (bf16_t*)(F.ws + WS_WIN) + (size_t)l * 8192 * 1024;
        { TrJob j{wl, NIN, D, 2560, WinT, D, 0, 0, 0, 0.f}; tr_run(F, j, base, nxt); }
        { TrJob j{wl + 2576, NIN, D, 2048, WinT, D, 2560, 0, 0, 0.f}; tr_run(F, j, base, nxt); }
        if (l == 0) { TrJob j{wl + 4632, NIN, D, 512, WinT, D, 4608, 0, 0, 0.f}; tr_run(F, j, base, nxt); return; }
        { TrJob j{wl + 4632, NIN, D, 3584, WinT, D, 4608, 0, 0, 0.f}; tr_run(F, j, base, nxt); }
        bf16_t* WupT = (bf16_t*)(F.ws + WS_WUP) + (size_t)l * 3072 * 512;
#pragma unroll
        for (int br = 0; br < 3; ++br) { TrJob j{A->in[9 + br] + (size_t)l * 512 * 1024, 1024, 512, 1024, WupT, 512, br * 1024, 0, 0, 0.f}; tr_run(F, j, base, nxt); }
        { TrJob j{A->in[12] + (size_t)l * D * D, D, D, D, (bf16_t*)(F.ws + WS_WO3) + (size_t)l * 1024 * 1024, D, 0, 0, 0, 0.f}; tr_run(F, j, base, nxt); }
    }
    if (part == 1) {
        { TrJob j{A->in[14], DFF, D, DFF, (bf16_t*)(F.ws + WS_WFGU), D, 0, 0, 1, 0.f}; tr_run(F, j, base, nxt); }
        { TrJob j{A->in[15], DFF, D, DFF, (bf16_t*)(F.ws + WS_WFGU), D, 128, 0, 1, 0.f}; tr_run(F, j, base, nxt); }
        { TrJob j{A->in[16], D, DFF, D, (bf16_t*)(F.ws + WS_WFD), DFF, 0, 0, 0, 0.f}; tr_run(F, j, base, nxt); }
    }
}
DEV void p_prep_l0_late(Frame& F, CArgs A) {
    const int first = F.G > 192 ? 192 : 0; if (F.vcu < first) return;
    int base = 0, nxt = (F.vcu - first) * NWAVES + F.wave; const int stride = (F.G - first) * NWAVES;
    const float* wl = A->in[2]; bf16_t* WinT = (bf16_t*)(F.ws + WS_WIN);
    { TrJob j{wl + 5144, NIN, D, 3072, WinT, D, 5120, 0, 0, 0.f}; tr_run(F, j, base, nxt, stride); }
    bf16_t* WupT = (bf16_t*)(F.ws + WS_WUP);
#pragma unroll
    for (int br = 0; br < 3; ++br) { TrJob j{A->in[9 + br], 1024, 512, 1024, WupT, 512, br * 1024, 0, 0, 0.f}; tr_run(F, j, base, nxt, stride); }
    { TrJob j{A->in[12], D, D, D, (bf16_t*)(F.ws + WS_WO3), D, 0, 0, 0, 0.f}; tr_run(F, j, base, nxt, stride); }
}
DEV void p_sample_moe_amax(Frame& F, CArgs A) {
    LAS float* red = (LAS float*)(F.lds + LDSCTL_OFF + 2048);
#pragma unroll
    for (int t = 0; t < 3; ++t) { const f32x4* src = (const f32x4*)A->in[19 + t]; float m = 0.f;
#pragma unroll
        for (int i = 0; i < 2; ++i) { const f32x4 v = src[(size_t)(F.gw * 2 + i) * ((size_t)8 * D * DFF / 4 / (2 * F.NGW)) + F.lane]; m = fmaxf(m, fmaxf(fmaxf(fabsf(v[0]), fabsf(v[1])), fmaxf(fabsf(v[2]), fabsf(v[3])))); }
        m = wave_max(m); if (F.lane == 0) red[t * 8 + F.wave] = m; }
    __syncthreads();
    if (F.tid < 3) { float m = red[F.tid * 8];
#pragma unroll
        for (int w = 1; w < 8; ++w) m = fmaxf(m, red[F.tid * 8 + w]);
        __hip_atomic_fetch_max((unsigned*)(F.ws + WS_CTL) + CW_WAMAX + 64 * F.tid, __float_as_uint(m), __ATOMIC_RELAXED, __HIP_MEMORY_SCOPE_AGENT); }
}
DEV void p_prep_moe_weights(Frame& F, CArgs A) {
    int base = 0, nxt = F.gw; const float* wam = (const float*)(F.ws + WS_CTL) + CW_WAMAX; const float qg = pow2_scale(wam[0]), qu = pow2_scale(wam[64]), qd = pow2_scale(wam[128]);
    for (int e = 0; e < 8; ++e) {
        unsigned char* GU8 = F.ws + WS_MGU + (size_t)e * 5632 * 1024; unsigned char* DW8 = F.ws + WS_MD + (size_t)e * 1024 * DFF;
        { TrJob j{A->in[19] + (size_t)e * D * DFF, DFF, D, DFF, (bf16_t*)GU8, D, 0, 0, 1, qg}; tr_run(F, j, base, nxt); }
        { TrJob j{A->in[20] + (size_t)e * D * DFF, DFF, D, DFF, (bf16_t*)GU8, D, 128, 0, 1, qu}; tr_run(F, j, base, nxt); }
        { TrJob j{A->in[21] + (size_t)e * D * DFF, D, DFF, D, (bf16_t*)DW8, DFF, 0, 0, 0, qd}; tr_run(F, j, base, nxt); }
    }
}
DEV void p_rope_table(Frame& F) {
    float* cs = (float*)(F.ws + WS_ROPE_COS); float* sn = (float*)(F.ws + WS_ROPE_SIN);
    for (int idx = F.vcu * NTHREADS + F.tid; idx < SEQ * 8; idx += F.G * NTHREADS) {
        const int s = idx >> 3, i = idx & 7; const float inv = (float)pow(500000.0, -(double)i / 8.0); const float ang = (float)s * inv;
        cs[idx] = (float)cos((double)ang); sn[idx] = (float)sin((double)ang); }
}

template <int NS, bool XBF = false, bool Q8 = false>
DEV void p_norm(Frame& F, const float* X, const float* g, bf16_t* XN, const float* W, int ldw, int c0a, int c0b, const float* bias, float* ZS, int* tope, float* topg) {
    LAS float* Wl = (LAS float*)F.lds; LAS unsigned* lcnt = (LAS unsigned*)(F.lds + 32768); LAS unsigned* lbase = lcnt + 8; LAS unsigned* stash = lcnt + 64 + F.wave * 32;
    if (NS == 8 && F.tid < 8) lcnt[F.tid] = 0u;
    int it_ = 0;
    if (NS > 0) {
        f32x4 wv[2][6];
#pragma unroll
        for (int p = 0; p < 2; ++p) { const float* wr = W + (size_t)(F.tid + 512 * p) * ldw;
#pragma unroll
            for (int q = 0; q < NS / 4; ++q) wv[p][q] = *(const f32x4*)(wr + ((NS == 24 && q >= 4) ? c0b + 4 * (q - 4) : c0a + 4 * q)); }
#pragma unroll
        for (int p = 0; p < 2; ++p)
#pragma unroll
            for (int q = 0; q < NS / 4; ++q)
#pragma unroll
                for (int i = 0; i < 4; ++i) { if (NS == 24) *(LAS bf16_t*)(F.lds + (4 * q + i) * 2064 + (F.tid + 512 * p) * 2) = f2bf(wv[p][q][i]); else Wl[(4 * q + i) * D + F.tid + 512 * p] = wv[p][q][i]; }
        if (NS == 24) { for (int idx = F.tid; idx < 8 * 1024; idx += NTHREADS) *(LAS bf16_t*)(F.lds + (24 + (idx >> 10)) * 2064 + (idx & 1023) * 2) = 0; }
        __syncthreads();
    }
    f32x4 gg[4];
#pragma unroll
    for (int j = 0; j < 4; ++j) gg[j] = ((const f32x4*)g + F.lane)[64 * j];
    for (int mb = F.gw; mb < T; mb += 4 * F.NGW) {
      f32x4 vv[4][4];
#pragma unroll
      for (int u = 0; u < 4; ++u) { const int mu = mb + u * F.NGW; if (mu < T) {
          if (XBF) { const uint2* xr = (const uint2*)((const bf16_t*)X + (size_t)mu * D) + F.lane;
#pragma unroll
              for (int j = 0; j < 4; ++j) { const uint2 w = xr[64 * j]; vv[u][j] = (f32x4){__uint_as_float(w.x << 16), __uint_as_float(w.x & 0xffff0000u), __uint_as_float(w.y << 16), __uint_as_float(w.y & 0xffff0000u)}; } }
          else { const f32x4* xr = (const f32x4*)(X + (size_t)mu * D) + F.lane;
#pragma unroll
              for (int j = 0; j < 4; ++j) vv[u][j] = __builtin_nontemporal_load(xr + 64 * j); } } }
#pragma unroll
      for (int u = 0; u < 4; ++u) { const int m = mb + u * F.NGW; if (m >= T) break;
        f32x4 v[4]; float ss = 0.f;
#pragma unroll
        for (int j = 0; j < 4; ++j) { v[j] = vv[u][j]; ss += v[j][0] * v[j][0] + v[j][1] * v[j][1] + v[j][2] * v[j][2] + v[j][3] * v[j][3]; }
        const float rstd = rsqrtf(wave_sum(ss) * (1.f / D) + EPS);
#pragma unroll
        for (int j = 0; j < 4; ++j) v[j] = v[j] * rstd * gg[j];
        if (Q8) {
            float am = 0.f;
#pragma unroll
            for (int j = 0; j < 4; ++j) am = fmaxf(am, fmaxf(fmaxf(fabsf(v[j][0]), fabsf(v[j][1])), fmaxf(fabsf(v[j][2]), fabsf(v[j][3]))));
            am = fmaxf(wave_max(am), 1e-30f); const float q = 240.f / am; unsigned* o8 = (unsigned*)((unsigned char*)XN + (size_t)m * D) + F.lane;
#pragma unroll
            for (int j = 0; j < 4; ++j) o8[64 * j] = pk4_fp8(v[j][0] * q, v[j][1] * q, v[j][2] * q, v[j][3] * q);
            if (F.lane == 0) ((float*)(F.ws + WS_RS))[m] = am * (1.f / 240.f);
        } else {
        uint2* o = (uint2*)(XN + (size_t)m * D) + F.lane;
#pragma unroll
        for (int j = 0; j < 4; ++j) { uint2 w; w.x = pk2(v[j][0], v[j][1]); w.y = pk2(v[j][2], v[j][3]); o[64 * j] = w; }
        }
        if (NS == 8) {
            float lg[8];
#pragma unroll
            for (int c = 0; c < 8; ++c) { const LAS f32x4* wr = (const LAS f32x4*)(Wl + c * D) + F.lane; float a = 0.f;
#pragma unroll
                for (int j = 0; j < 4; ++j) { const f32x4 w = wr[64 * j]; a += v[j][0] * w[0] + v[j][1] * w[1] + v[j][2] * w[2] + v[j][3] * w[3]; }
                lg[c] = wave_sum(a) + bias[c]; }
            int e1 = 0; float l1 = lg[0];
#pragma unroll
            for (int c = 1; c < 8; ++c) if (lg[c] > l1) { l1 = lg[c]; e1 = c; }
            int e2 = -1; float l2 = -INFINITY;
#pragma unroll
            for (int c = 0; c < 8; ++c) if (c != e1 && lg[c] > l2) { l2 = lg[c]; e2 = c; }
            if (F.lane == 0) { const float g2 = 1.f / (1.f + __expf(l1 - l2)); tope[m * 2] = e1; tope[m * 2 + 1] = e2; topg[m * 2] = 1.f - g2; topg[m * 2 + 1] = g2;
                stash[(it_ & 15) * 2] = ((unsigned)e1 << 16) | __hip_atomic_fetch_add(lcnt + e1, 1u, __ATOMIC_RELAXED, __HIP_MEMORY_SCOPE_WORKGROUP);
                stash[(it_ & 15) * 2 + 1] = ((unsigned)e2 << 16) | __hip_atomic_fetch_add(lcnt + e2, 1u, __ATOMIC_RELAXED, __HIP_MEMORY_SCOPE_WORKGROUP); }
            ++it_;
        }
      }
    }
    if (NS > 0) __syncthreads();
    if (NS == 24) {
        const int ti = F.wave >> 2, kq = F.wave & 3, r = F.lane & 31, hh = F.lane >> 5; const int rows_per = (T + F.NGW - 1) / F.NGW;
        const int it_r = 4 * ti + (r >> 3); int mrow = F.vcu * NWAVES + (r & 7) + F.NGW * it_r; const bool rok = it_r < rows_per && mrow < T; if (!rok) mrow = 0;
        const bf16_t* arow = XN + (size_t)mrow * D + kq * 256 + 8 * hh; const LAS unsigned char* brow = F.lds + r * 2064 + (kq * 256 + 8 * hh) * 2; f32x16 acc = {};
        bf16x8 af[16];
#pragma unroll
        for (int k = 0; k < 16; ++k) af[k] = *(const bf16x8*)(arow + 16 * k);
#pragma unroll
        for (int k = 0; k < 16; ++k) acc = MFMA32(af[k], *(const LAS bf16x8*)(brow + 32 * k), acc);
        LAS float* PART = (LAS float*)(F.lds + 69632) + F.wave * 1024;
#pragma unroll
        for (int g = 0; g < 16; ++g) PART[crow(g, hh) * 32 + r] = acc[g];
        __syncthreads();
        { const int t2 = F.tid >> 8, idx = F.tid & 255, rr = idx >> 3, cg = idx & 7; const LAS float* P0 = (const LAS float*)(F.lds + 69632) + t2 * 4096 + rr * 32 + cg * 4;
          const f32x4 sum = *(const LAS f32x4*)P0 + *(const LAS f32x4*)(P0 + 1024) + *(const LAS f32x4*)(P0 + 2048) + *(const LAS f32x4*)(P0 + 3072);
          const int it2 = 4 * t2 + (rr >> 3), m2 = F.vcu * NWAVES + (rr & 7) + F.NGW * it2;
          if (cg < 6 && it2 < rows_per && m2 < T) { const int cb_ = (cg < 4) ? c0a + 4 * cg : c0b + 4 * (cg - 4); *(f32x4*)(ZS + (size_t)m2 * 24 + 4 * cg) = sum + *(const f32x4*)(bias + cb_); } }
        __syncthreads();
    }
    if (NS == 8) {
        if (F.tid < 8) lbase[F.tid] = __hip_atomic_fetch_add((unsigned*)(F.ws + WS_CTL) + CW_MOECNT + 64 * F.tid, lcnt[F.tid], __ATOMIC_RELAXED, __HIP_MEMORY_SCOPE_AGENT);
        __syncthreads();
        int* POS = (int*)(F.ws + WS_SLOT); int i2 = 0;
        for (int m = F.gw; m < T; m += F.NGW) { if (F.lane < 2) { const unsigned st = stash[(i2 & 15) * 2 + F.lane]; POS[m * 2 + F.lane] = (int)(lbase[st >> 16] + (st & 0xffffu)); } ++i2; }
        __syncthreads();
    }
}

DEV void p_mixer_prep(Frame& F, CArgs A, int l) {
    bf16_t* ZA = (bf16_t*)(F.ws + WS_ZA); const float* cs = (const float*)(F.ws + WS_ROPE_COS); const float* sn = (const float*)(F.ws + WS_ROPE_SIN);
    const int gt = F.vcu * NTHREADS + F.tid, NT = F.G * NTHREADS;
    float* KM = (float*)(F.ws + WS_KM); LAS float* red = (LAS float*)F.lds;
    for (int it = F.vcu; it < 512; it += F.G) { const int j = it & 31, h = (it >> 5) & 7, b = it >> 8, s0 = j * 256 + 32 * F.wave;
        const int rw = F.lane >> 3, ch = F.lane & 7; bf16_t* base = ZA + (size_t)(b * SEQ + s0 + rw) * ZA_LD + ZA_MK + h * 64 + ch * 8;
        v4u raw[4]; f32x4 c0[4], c1[4], n0[4], n1[4];
#pragma unroll
        for (int i = 0; i < 4; ++i) raw[i] = *(const v4u*)(base + (size_t)(8 * i) * ZA_LD);
        if (ch < 2) {
#pragma unroll
            for (int i = 0; i < 4; ++i) { const float* cp = cs + (s0 + 8 * i + rw) * 8; const float* sp = sn + (s0 + 8 * i + rw) * 8; c0[i] = *(const f32x4*)cp; c1[i] = *(const f32x4*)(cp + 4); n0[i] = *(const f32x4*)sp; n1[i] = *(const f32x4*)(sp + 4); } }
        float a8[8];
#pragma unroll
        for (int k = 0; k < 8; ++k) a8[k] = 0.f;
#pragma unroll
        for (int i = 0; i < 4; ++i) { float f[8], o[8]; unpack8(raw[i], f);
#pragma unroll
            for (int k = 0; k < 8; ++k) o[k] = __shfl_xor(f[k], 1);
            if (ch < 2) { const float cc[8] = {c0[i][0], c0[i][1], c0[i][2], c0[i][3], c1[i][0], c1[i][1], c1[i][2], c1[i][3]}, ss[8] = {n0[i][0], n0[i][1], n0[i][2], n0[i][3], n1[i][0], n1[i][1], n1[i][2], n1[i][3]};
#pragma unroll
                for (int k = 0; k < 8; ++k) f[k] = (ch == 0) ? (f[k] * cc[k] - o[k] * ss[k]) : (f[k] * cc[k] + o[k] * ss[k]);
                const v4u pk = pack8(f); *(v4u*)(base + (size_t)(8 * i) * ZA_LD) = pk; unpack8(pk, f); }
#pragma unroll
            for (int k = 0; k < 8; ++k) a8[k] += f[k]; }
#pragma unroll
        for (int k = 0; k < 8; ++k) { a8[k] += __shfl_xor(a8[k], 8); a8[k] += __shfl_xor(a8[k], 16); a8[k] += __shfl_xor(a8[k], 32); }
        if (rw == 0) {
#pragma unroll
            for (int k = 0; k < 8; ++k) red[F.wave * 64 + ch * 8 + k] = a8[k]; }
        __syncthreads();
        if (F.wave == 0) { float t = 0.f;
#pragma unroll
            for (int w = 0; w < 8; ++w) t += red[w * 64 + F.lane];
            KM[(size_t)it * 64 + F.lane] = t * (1.f / 256.f); }
        __syncthreads(); }
}

DEV void p_route_gather(Frame& F) {
    const unsigned* gcnt = (const unsigned*)(F.ws + WS_CTL) + CW_MOECNT; const int* tope = (const int*)(F.ws + WS_TOPE); int* slot = (int*)(F.ws + WS_SLOT);
    int cnt[8], pst[8], pad0[8]; int run = 0, prun = 0;
#pragma unroll
    for (int e = 0; e < 8; ++e) { cnt[e] = (int)__builtin_amdgcn_readfirstlane(gcnt[64 * e]); pst[e] = run; pad0[e] = prun; const int padded = (cnt[e] + 255) & ~255; run += padded; prun += padded - cnt[e]; }
    if (F.vcu == 0 && F.tid == 0) { int* blk_e = (int*)(F.ws + WS_BLK_E); int nb = 0;
#pragma unroll
        for (int e = 0; e < 8; ++e) { const int nbe = (cnt[e] + 255) >> 8; for (int j = 0; j < nbe; ++j) blk_e[nb++] = e; }
        *(int*)(F.ws + WS_NBLK) = nb;
        int* TQ = (int*)(F.ws + WS_ROWS_TOK); const int units = nb * 4, R = units / F.G, Lc = units - R * F.G; const int ns = 0;
        (void)units;
        TQ[1024] = ns; TQ[1025] = R; }
    const unsigned char* XQ = F.ws + WS_XN2; unsigned char* XG8 = F.ws + WS_YM; const float* RS = (const float*)(F.ws + WS_RS); float* RSG = (float*)(F.ws + WS_RSG);
    for (int mb = F.gw; mb < T; mb += 4 * F.NGW) { v4u ra[4]; float rsv[4]; int ee[4][2], pp[4][2];
#pragma unroll
        for (int u = 0; u < 4; ++u) { const int m = mb + u * F.NGW < T ? mb + u * F.NGW : mb; ra[u] = __builtin_nontemporal_load((const v4u*)(XQ + (size_t)m * D) + F.lane); rsv[u] = RS[m];
            ee[u][0] = tope[m * 2]; ee[u][1] = tope[m * 2 + 1]; pp[u][0] = slot[m * 2]; pp[u][1] = slot[m * 2 + 1]; }
#pragma unroll
        for (int u = 0; u < 4; ++u) { const int m = mb + u * F.NGW; if (m >= T) break;
#pragma unroll
            for (int k = 0; k < 2; ++k) { const int e = ee[u][k]; int ps = 0;
#pragma unroll
                for (int q = 0; q < 8; ++q) ps = (e == q) ? pst[q] : ps;
                const int dest = ps + pp[u][k]; ((v4u*)(XG8 + (size_t)dest * D))[F.lane] = ra[u];
                if (F.lane == 0) { slot[m * 2 + k] = dest; RSG[dest] = rsv[u]; } } } }
    for (int r = F.gw; r < prun; r += F.NGW) { int row = 0;
#pragma unroll
        for (int e = 0; e < 8; ++e) { if (r >= pad0[e]) row = pst[e] + cnt[e] + (r - pad0[e]); }
        const v4u z = {0u, 0u, 0u, 0u}; ((v4u*)(XG8 + (size_t)row * D))[F.lane] = z; if (F.lane == 0) RSG[row] = 0.f; }
}
DEV void p_combine_final(Frame& F, CArgs A) {
    float* X = F.X; const bf16_t* XBr = (const bf16_t*)(F.ws + WS_XB); const bf16_t* YM = (const bf16_t*)(F.ws + WS_YM); const int* slot = (const int*)(F.ws + WS_SLOT); const float* topg = (const float*)(F.ws + WS_TOPG); const f32x4* gr = (const f32x4*)A->in[22] + F.lane;
    f32x4 gg[4];
#pragma unroll
    for (int j = 0; j < 4; ++j) gg[j] = gr[64 * j];
    const int* TQ = (const int*)(F.ws + WS_ROWS_TOK); const bf16_t* YB = (const bf16_t*)(F.ws + WS_XN2); const int nsplit_ = TQ[1024];
    for (int mb = F.gw; mb < T; mb += 4 * F.NGW) {
        int s0[4], s1[4]; float g0[4], g1[4]; f32x4 xv[4][4]; uint2 ya[4][4], yb[4][4];
#pragma unroll
        for (int u = 0; u < 4; ++u) { const int m = mb + u * F.NGW < T ? mb + u * F.NGW : mb; s0[u] = slot[m * 2]; s1[u] = slot[m * 2 + 1]; g0[u] = topg[m * 2]; g1[u] = topg[m * 2 + 1];
            const uint2* xr = (const uint2*)(XBr + (size_t)m * D) + F.lane;
#pragma unroll
            for (int j = 0; j < 4; ++j) { const uint2 w = xr[64 * j]; xv[u][j] = (f32x4){__uint_as_float(w.x << 16), __uint_as_float(w.x & 0xffff0000u), __uint_as_float(w.y << 16), __uint_as_float(w.y & 0xffff0000u)}; } }
#pragma unroll
        for (int u = 0; u < 4; ++u) { const uint2* y0 = (const uint2*)(YM + (size_t)s0[u] * D) + F.lane; const uint2* y1 = (const uint2*)(YM + (size_t)s1[u] * D) + F.lane;
#pragma unroll
            for (int j = 0; j < 4; ++j) { typedef unsigned u32x2n __attribute__((ext_vector_type(2))); const u32x2n a_ = __builtin_nontemporal_load((const u32x2n*)(y0 + 64 * j)), b_ = __builtin_nontemporal_load((const u32x2n*)(y1 + 64 * j)); ya[u][j] = make_uint2(a_.x, a_.y); yb[u][j] = make_uint2(b_.x, b_.y); } }
        if (nsplit_ > 0) {
#pragma unroll
            for (int u = 0; u < 4; ++u)
#pragma unroll
                for (int j = 0; j < 4; ++j) { const int q0 = TQ[(s0[u] >> 8) * 4 + j], q1 = TQ[(s1[u] >> 8) * 4 + j];
                    if (q0 >= 0) { const uint2 e = *((const uint2*)(YB + (size_t)q0 * 65536 + (s0[u] & 255) * 256) + F.lane); xv[u][j] += g0[u] * (f32x4){__uint_as_float(e.x << 16), __uint_as_float(e.x & 0xffff0000u), __uint_as_float(e.y << 16), __uint_as_float(e.y & 0xffff0000u)}; }
                    if (q1 >= 0) { const uint2 e = *((const uint2*)(YB + (size_t)q1 * 65536 + (s1[u] & 255) * 256) + F.lane); xv[u][j] += g1[u] * (f32x4){__uint_as_float(e.x << 16), __uint_as_float(e.x & 0xffff0000u), __uint_as_float(e.y << 16), __uint_as_float(e.y & 0xffff0000u)}; } } }
#pragma unroll
        for (int u = 0; u < 4; ++u) { const int m = mb + u * F.NGW; if (m >= T) break;
            f32x4 v[4]; float ss = 0.f;
#pragma unroll
            for (int j = 0; j < 4; ++j) { v[j] = xv[u][j]; const uint2 a = ya[u][j], c = yb[u][j];
                v[j][0] += g0[u] * __uint_as_float(a.x << 16) + g1[u] * __uint_as_float(c.x << 16); v[j][1] += g0[u] * __uint_as_float(a.x & 0xffff0000u) + g1[u] * __uint_as_float(c.x & 0xffff0000u);
                v[j][2] += g0[u] * __uint_as_float(a.y << 16) + g1[u] * __uint_as_float(c.y << 16); v[j][3] += g0[u] * __uint_as_float(a.y & 0xffff0000u) + g1[u] * __uint_as_float(c.y & 0xffff0000u);
                ss += v[j][0] * v[j][0] + v[j][1] * v[j][1] + v[j][2] * v[j][2] + v[j][3] * v[j][3]; }
            const float rstd = rsqrtf(wave_sum(ss) * (1.f / D) + EPS); f32x4* xo = (f32x4*)(X + (size_t)m * D) + F.lane;
#pragma unroll
            for (int j = 0; j < 4; ++j) __builtin_nontemporal_store(v[j] * rstd * gg[j], xo + 64 * j); }
    }
}

namespace attn_body {
using bf16=__hip_bfloat16;
using bf16x8=__attribute__((ext_vector_type(8)))short;
using s16x4=__attribute__((ext_vector_type(4)))short;
using f32x16=__attribute__((ext_vector_type(16)))float;
using u32x4=__attribute__((ext_vector_type(4)))unsigned;
constexpr int BATCH=2,NHEAD=8,SEQ=8192,D=64,PQ=5120,PO=512;
constexpr int NW=8,QBLK=32,QB=QBLK*NW,KVBLK=64,NQB=SEQ/QB;
constexpr int ATTN_UNIT_ROWS=QB;
__device__ __forceinline__ int crow(int r,int hi){return (r&3)+8*(r>>2)+4*hi;}
#define SBAR() __builtin_amdgcn_sched_barrier(0)
__device__ __forceinline__ void cmask(f32x16&p0,f32x16&p1,int jb,int qrel,int hi){
  const float NEG=-INFINITY; int kb=64*jb+4*hi;
  #pragma unroll
  for(int r=0;r<16;++r){int kv=kb+(r&3)+8*(r>>2); if(kv>qrel)p0[r]=NEG; if(kv+32>qrel)p1[r]=NEG;}
}

constexpr int NSLOT=3, SLOTB=8192;
constexpr int LDS_K=0, LDS_V=NSLOT*SLOTB, LDS_WS=2*NSLOT*SLOTB, LDS_OST=LDS_WS+NW*64*4, LDS_BYTES=LDS_OST+NW*4096;
constexpr float C2=0.125f*1.4426950408889634f;
__device__ __forceinline__ void glds16(const void*gsrc,unsigned lds_dst){unsigned keep;
  asm volatile("s_mov_b32 %0, m0\n\ts_mov_b32 m0, %2\n\ts_nop 0\n\tglobal_load_lds_dwordx4 %1, off\n\ts_mov_b32 m0, %0":"=&s"(keep):"v"(gsrc),"s"(lds_dst):"memory");}
__device__ __forceinline__ float max3f(float a,float b,float c){float r;asm("v_max3_f32 %0, %1, %2, %3":"=v"(r):"v"(a),"v"(b),"v"(c));return r;}
__device__ __forceinline__ float max2f(float a,float b){float r;asm("v_max_f32_e32 %0, %1, %2":"=v"(r):"v"(a),"v"(b));return r;}
__device__ __forceinline__ float fadd_s(float a,float b){float r;asm("v_add_f32_e32 %0, %1, %2":"=v"(r):"v"(a),"v"(b));return r;}
__device__ __forceinline__ float fsub_s(float a,float b){float r;asm("v_sub_f32_e32 %0, %1, %2":"=v"(r):"v"(a),"v"(b));return r;}
typedef float f32x2_t __attribute__((ext_vector_type(2))); typedef __bf16 bf16x2_t __attribute__((ext_vector_type(2)));
__device__ __forceinline__ unsigned cvtpk_s(float lo,float hi){f32x2_t v={lo,hi};bf16x2_t b=__builtin_convertvector(v,bf16x2_t);return __builtin_bit_cast(unsigned,b);}
#define WAIT_BAR(N) asm volatile("s_waitcnt vmcnt(" #N ") lgkmcnt(0)\n\ts_barrier":::"memory")

__device__ __forceinline__ void qkt(f32x16&p0,f32x16&p1,const char*Kslot,const bf16x8*qr,const f32x16&negm,int r32,int hi){
  const char*kb=Kslot+hi*1024+r32*16;
  #pragma unroll
  for(int d0=0;d0<4;++d0){
    const bf16x8 b0=*reinterpret_cast<const bf16x8*>(kb+d0*2048);
    const bf16x8 b1=*reinterpret_cast<const bf16x8*>(kb+d0*2048+512);
    if(d0==0){p0=__builtin_amdgcn_mfma_f32_32x32x16_bf16(b0,qr[0],negm,0,0,0);p1=__builtin_amdgcn_mfma_f32_32x32x16_bf16(b1,qr[0],negm,0,0,0);}
    else{p0=__builtin_amdgcn_mfma_f32_32x32x16_bf16(b0,qr[d0],p0,0,0,0);p1=__builtin_amdgcn_mfma_f32_32x32x16_bf16(b1,qr[d0],p1,0,0,0);}}
}
typedef __attribute__((address_space(3))) const char* lds_cptr;
typedef short v4i16_t __attribute__((ext_vector_type(4)));
__device__ __forceinline__ void kload8(bf16x8*kf,lds_cptr kp){
  kf[0]=*(const __attribute__((address_space(3))) bf16x8*)(kp);      kf[1]=*(const __attribute__((address_space(3))) bf16x8*)(kp+512);
  kf[2]=*(const __attribute__((address_space(3))) bf16x8*)(kp+2048); kf[3]=*(const __attribute__((address_space(3))) bf16x8*)(kp+2560);
  kf[4]=*(const __attribute__((address_space(3))) bf16x8*)(kp+4096); kf[5]=*(const __attribute__((address_space(3))) bf16x8*)(kp+4608);
  kf[6]=*(const __attribute__((address_space(3))) bf16x8*)(kp+6144); kf[7]=*(const __attribute__((address_space(3))) bf16x8*)(kp+6656);
}
__device__ __forceinline__ void kload2(bf16x8*kf,lds_cptr kp,int j){ kf[2*j]=*(const __attribute__((address_space(3))) bf16x8*)(kp+j*2048); kf[2*j+1]=*(const __attribute__((address_space(3))) bf16x8*)(kp+j*2048+512); }
__device__ __forceinline__ s16x4 vtr(lds_cptr p){ return __builtin_bit_cast(s16x4,__builtin_amdgcn_ds_read_tr16_b64_v4i16((__attribute__((address_space(3))) v4i16_t*)p)); }
__device__ __forceinline__ float rowmax(const f32x16&p0,const f32x16&p1){
  float a=max3f(p0[0],p0[1],p1[0]),b=max3f(p0[2],p0[3],p1[1]);a=max3f(a,p1[2],p1[3]);
  #pragma unroll
  for(int r=4;r<16;r+=4){a=max3f(a,p0[r],p0[r+1]);b=max3f(b,p0[r+2],p0[r+3]);a=max3f(a,p1[r],p1[r+1]);b=max3f(b,p1[r+2],p1[r+3]);}
  const float m=max2f(a,b);
  auto rr=__builtin_amdgcn_permlane32_swap(__float_as_uint(m),__float_as_uint(m),false,false);
  return max2f(__uint_as_float(rr[0]),__uint_as_float(rr[1]));
}
__device__ __forceinline__ void pv(f32x16*o,int vb,bf16x8 pa0,bf16x8 pa1,bf16x8 pa2,bf16x8 pa3){
  #pragma unroll
  for(int d0=0;d0<2;++d0){s16x4 lo[4],hi[4];
    #pragma unroll
    for(int ks=0;ks<4;++ks){
      asm volatile("ds_read_b64_tr_b16 %0,%1 offset:%c2":"=&v"(lo[ks]):"v"(vb),"i"(d0*4096+ks*1024):"memory");
      asm volatile("ds_read_b64_tr_b16 %0,%1 offset:%c2":"=&v"(hi[ks]):"v"(vb),"i"(d0*4096+ks*1024+512):"memory");}
    asm volatile("s_waitcnt lgkmcnt(0)":::"memory");SBAR();
    #define PK(k) (bf16x8){lo[k][0],lo[k][1],lo[k][2],lo[k][3],hi[k][0],hi[k][1],hi[k][2],hi[k][3]}
    o[d0]=__builtin_amdgcn_mfma_f32_32x32x16_bf16(pa0,PK(0),o[d0],0,0,0);
    o[d0]=__builtin_amdgcn_mfma_f32_32x32x16_bf16(pa1,PK(1),o[d0],0,0,0);
    o[d0]=__builtin_amdgcn_mfma_f32_32x32x16_bf16(pa2,PK(2),o[d0],0,0,0);
    o[d0]=__builtin_amdgcn_mfma_f32_32x32x16_bf16(pa3,PK(3),o[d0],0,0,0);
    #undef PK
  }
}

#ifndef ATTN_STORE16
#define ATTN_STORE16(p,v) (*(u32x4*)(p)=(v))
#endif
template<int THRL,bool CAUSAL> __device__ __forceinline__ void attn_unit(int tid,int b,int h,int jb,const unsigned short*list,int g,int cnt,const bf16*Q,const bf16*__restrict__ K,const bf16*__restrict__ V,bf16*PO,float*ML,const float*rcs,const float*rsn,char*shm){
  const int lane=tid&63,r32=lane&31,hi=lane>>5; const int wid=__builtin_amdgcn_readfirstlane(tid>>6);
  const long rowbase=(long)b*SEQ;
  int s_,rank_; bool valid_;
  if(CAUSAL){ s_=jb*QB+wid*QBLK+r32; rank_=3; valid_=true; }
  else{ const int li=g*QB+wid*QBLK+r32; valid_=li<cnt; const unsigned e_=list[valid_?li:0]; s_=(int)(e_&0x1fffu); rank_=(int)(e_>>13); }
  const bf16*Qrow=Q+(rowbase+s_)*PQ+h*D;
  const bf16*Kh=K+(rowbase+(long)jb*QB)*PQ+h*D,*Vh=V+(rowbase+(long)jb*QB)*PQ+h*D;
  const unsigned lds0=(unsigned)(uintptr_t)shm;
  float*wsf=(float*)(shm+LDS_WS)+wid*64;
  const bf16*ksrc=Kh+(long)lane*PQ+wid*8;
  const bf16*vsrc=Vh+(long)(16*(wid&3)+(lane>>2))*PQ+(wid>>2)*32+(lane&3)*8;
  const unsigned kdst=lds0+LDS_K+wid*1024, vdst=lds0+LDS_V+wid*1024;
  #define TSRC(u) (u)
  #define DMA_K(t,slot) glds16(ksrc+(long)TSRC(t)*KVBLK*PQ,(unsigned)__builtin_amdgcn_readfirstlane(kdst+(slot)))
  #define DMA_V(t,slot) glds16(vsrc+(long)TSRC(t)*KVBLK*PQ,(unsigned)__builtin_amdgcn_readfirstlane(vdst+(slot)))
  const int vb0=(int)(lds0+LDS_V)+((lane>>4)&1)*32+(lane&3)*8+(4*hi+((lane&15)>>2))*64;
  const char*Kbase=shm+LDS_K; bf16x8 kf[8];
  const lds_cptr shm3=(lds_cptr)shm; const lds_cptr kp0=shm3+LDS_K+hi*1024+r32*16; const lds_cptr vp0=shm3+LDS_V+((lane>>4)&1)*32+(lane&3)*8+(4*hi+((lane&15)>>2))*64;
  constexpr int NT=4;
  DMA_K(0,0);DMA_V(0,0);DMA_K(1,SLOTB);
  bf16x8 qr[4];
  #pragma unroll
  for(int d0=0;d0<4;++d0)qr[d0]=*reinterpret_cast<const bf16x8*>(&Qrow[d0*16+hi*8]);
  {
    typedef float f4_t __attribute__((ext_vector_type(4))); const f4_t c0=*reinterpret_cast<const f4_t*>(rcs+s_*8),c1=*reinterpret_cast<const f4_t*>(rcs+s_*8+4),n0=*reinterpret_cast<const f4_t*>(rsn+s_*8),n1=*reinterpret_cast<const f4_t*>(rsn+s_*8+4);
    const float cc_[8]={c0[0],c0[1],c0[2],c0[3],c1[0],c1[1],c1[2],c1[3]}, ss_[8]={n0[0],n0[1],n0[2],n0[3],n1[0],n1[1],n1[2],n1[3]};
    #pragma unroll
    for(int d0=0;d0<4;++d0){ float f_[8];
      #pragma unroll
      for(int i=0;i<8;++i)f_[i]=__uint_as_float(((unsigned)(unsigned short)qr[d0][i])<<16);
      if(d0==0){
        #pragma unroll
        for(int i=0;i<8;++i){ const float oth=__shfl_xor(f_[i],32); f_[i]=hi?(f_[i]*cc_[i]+oth*ss_[i]):(f_[i]*cc_[i]-oth*ss_[i]); } }
      #pragma unroll
      for(int i=0;i<8;i+=2){ const unsigned w_=cvtpk_s(f_[i]*C2,f_[i+1]*C2); qr[d0][i]=(short)(w_&0xffffu); qr[d0][i+1]=(short)(w_>>16); } } }
  float mhat=0.f,l_reg=0.f;f32x16 o[2];o[0]=f32x16{};o[1]=f32x16{};const f32x16 Z16=f32x16{};
  #define CMASK(P0,P1,t) do{ if((t)>0){ _Pragma("unroll") for(int r_=0;r_<16;++r_){P0[r_]-=mhat;P1[r_]-=mhat;} } \
    if(CAUSAL){ unsigned ln_; asm volatile("v_mbcnt_lo_u32_b32 %0, -1, 0\n\tv_mbcnt_hi_u32_b32 %0, -1, %0":"=v"(ln_)); cmask(P0,P1,(t),wid*QBLK+(int)(ln_&31u),(int)(ln_>>5)); } }while(0)
  bool resc=false;
  #define START(P0,P1) do{ const float rm=rowmax(P0,P1); resc=false; \
    { const float dl=rm; mhat=fadd_s(mhat,dl); \
      _Pragma("unroll") for(int r=0;r<16;++r){P0[r]=fsub_s(P0[r],dl);P1[r]=fsub_s(P1[r],dl);} \
      } \
    _Pragma("unroll") for(int r=0;r<16;++r)P0[r]=__builtin_amdgcn_exp2f(P0[r]); }while(0)
  #define RESC() do{ if(resc){ asm volatile("s_waitcnt lgkmcnt(0)":::"memory"); \
      _Pragma("unroll") for(int d_=0;d_<2;++d_) _Pragma("unroll") for(int r=0;r<16;++r)o[d_][r]*=wsf[crow(r,hi)]; } }while(0)
  f32x16 pA0,pA1,pB0,pB1;
  int sl_prev=0,sl_cur=0,sl_next=SLOTB;
  #define ROT() do{sl_prev=sl_cur;sl_cur=sl_next;sl_next=(sl_next==(NSLOT-1)*SLOTB)?0:sl_next+SLOTB;}while(0)
  DMA_K(2,2*SLOTB);
  WAIT_BAR(3);
  qkt(pA0,pA1,Kbase,qr,Z16,r32,hi);asm volatile("s_nop 15\n\ts_nop 7":"+v"(pA0),"+v"(pA1));CMASK(pA0,pA1,0);
  START(pA0,pA1);
  _Pragma("unroll") for(int r=0;r<16;++r)pA1[r]=__builtin_amdgcn_exp2f(pA1[r]);
  WAIT_BAR(0);
  DMA_K(3,0);DMA_V(1,SLOTB);
  ROT();
  kload8(kf,kp0+sl_cur);
  WAIT_BAR(2);
  s16x4 vlo[8],vhi[8]; u32x4 pw0,pw1,pw2,pw3;
  #define PKW(P,B) cvtpk_s(P[B],P[B+1])
  #define PAF(k) __builtin_bit_cast(bf16x8,pw##k)
  #define VFR(i) (bf16x8){vlo[i][0],vlo[i][1],vlo[i][2],vlo[i][3],vhi[i][0],vhi[i][1],vhi[i][2],vhi[i][3]}
  #define PIN(x) asm volatile("":"+v"(x))
  #define MX3(a,b,c) __builtin_fmaxf(__builtin_fmaxf((a),(b)),(c))
  #define GAPA(MF,A0,A1,A2,A3,W0,W1,PW) do{ MF; sacc+=A0; sacc+=A1; sacc+=A2; sacc+=A3; PIN(sacc); W0; W1; PIN(PW); SBAR(); }while(0)
  #define EX(v) __builtin_amdgcn_exp2f(v)
  #define GAPB(MF,X,B) do{ MF; X[B]=EX(X[B]); X[B+1]=EX(X[B+1]); X[B+2]=EX(X[B+2]); X[B+3]=EX(X[B+3]); PIN(X); SBAR(); }while(0)
  #define VRD(i) do{ vlo[i]=vtr(vp_+(((i)>>2)*4096+((i)&3)*1024)); vhi[i]=vtr(vp_+(((i)>>2)*4096+((i)&3)*1024+512)); }while(0)
  #define KRD(G,j) do{ if(G){ kload2(kf,kp0+sl_next,j); SBAR(); } }while(0)
  #define STEP(C0,C1,P0,P1,t,GK,GV,GL) do{ SBAR(); \
    const lds_cptr vp_=vp0+sl_prev; \
    VRD(0); SBAR(); float sacc=(P0[0]+P0[1]); \
    GAPA(C0=__builtin_amdgcn_mfma_f32_32x32x16_bf16(kf[0],qr[0],Z16,0,0,0), P0[2],P0[3],P0[4],P0[5],     pw0[0]=PKW(P0,0), pw0[1]=PKW(P0,2), pw0); \
    VRD(4); SBAR(); GAPA(C1=__builtin_amdgcn_mfma_f32_32x32x16_bf16(kf[1],qr[0],Z16,0,0,0), P0[6],P0[7],P0[8],P0[9],     pw0[2]=PKW(P0,4), pw0[3]=PKW(P0,6), pw0); \
    VRD(1); SBAR(); GAPA(C0=__builtin_amdgcn_mfma_f32_32x32x16_bf16(kf[2],qr[1],C0,0,0,0),   P0[10],P0[11],P0[12],P0[13], pw1[0]=PKW(P0,8), pw1[1]=PKW(P0,10), pw1); \
    VRD(5); SBAR(); GAPA(C1=__builtin_amdgcn_mfma_f32_32x32x16_bf16(kf[3],qr[1],C1,0,0,0),   P0[14],P0[15],P1[0],P1[1],   pw1[2]=PKW(P0,12),pw1[3]=PKW(P0,14), pw1); \
    VRD(2); SBAR(); GAPA(C0=__builtin_amdgcn_mfma_f32_32x32x16_bf16(kf[4],qr[2],C0,0,0,0),   P1[2],P1[3],P1[4],P1[5],     pw2[0]=PKW(P1,0), pw2[1]=PKW(P1,2), pw2); \
    VRD(6); SBAR(); GAPA(C1=__builtin_amdgcn_mfma_f32_32x32x16_bf16(kf[5],qr[2],C1,0,0,0),   P1[6],P1[7],P1[8],P1[9],     pw2[2]=PKW(P1,4), pw2[3]=PKW(P1,6), pw2); \
    VRD(3); SBAR(); GAPA(C0=__builtin_amdgcn_mfma_f32_32x32x16_bf16(kf[6],qr[3],C0,0,0,0),   P1[10],P1[11],P1[12],P1[13], pw3[0]=PKW(P1,8), pw3[1]=PKW(P1,10), pw3); \
    VRD(7); SBAR(); GAPA(C1=__builtin_amdgcn_mfma_f32_32x32x16_bf16(kf[7],qr[3],C1,0,0,0),   P1[14],P1[15],0.f,0.f,       pw3[2]=PKW(P1,12),pw3[3]=PKW(P1,14), pw3); \
    l_reg+=sacc; \
    if(GK){DMA_K((t)+3,sl_cur);} if(GV){DMA_V((t)+1,sl_next);} \
    CMASK(C0,C1,t); \
    { float a=MX3(C0[0],C0[1],C1[0]),b=MX3(C0[2],C0[3],C1[1]); a=MX3(a,C1[2],C1[3]); \
      _Pragma("unroll") for(int r=4;r<16;r+=4){a=MX3(a,C0[r],C0[r+1]);b=MX3(b,C0[r+2],C0[r+3]);a=MX3(a,C1[r],C1[r+1]);b=MX3(b,C1[r+2],C1[r+3]);} \
      float rm=__builtin_fmaxf(a,b); { auto rr=__builtin_amdgcn_permlane32_swap(__float_as_uint(rm),__float_as_uint(rm),false,false); rm=__builtin_fmaxf(__uint_as_float(rr[0]),__uint_as_float(rr[1])); } \
      resc=false; \
      if(__builtin_expect(__any(rm>(float)THRL),0)){ const float dl=(rm>(float)THRL)?rm:0.f; mhat+=dl;        \
        _Pragma("unroll") for(int r=0;r<16;++r){C0[r]-=dl;C1[r]-=dl;} \
        const float f=__builtin_amdgcn_exp2f(-dl); l_reg*=f; if(hi==0)wsf[r32]=f; resc=true; } } \
    SBAR(); \
    GAPB(o[0]=__builtin_amdgcn_mfma_f32_32x32x16_bf16(PAF(0),VFR(0),o[0],0,0,0), C0,0); \
    GAPB(o[1]=__builtin_amdgcn_mfma_f32_32x32x16_bf16(PAF(0),VFR(4),o[1],0,0,0), C0,4); \
    KRD(GL,0); GAPB(o[0]=__builtin_amdgcn_mfma_f32_32x32x16_bf16(PAF(1),VFR(1),o[0],0,0,0), C0,8); \
    KRD(GL,1); GAPB(o[1]=__builtin_amdgcn_mfma_f32_32x32x16_bf16(PAF(1),VFR(5),o[1],0,0,0), C0,12); \
    KRD(GL,2); GAPB(o[0]=__builtin_amdgcn_mfma_f32_32x32x16_bf16(PAF(2),VFR(2),o[0],0,0,0), C1,0); \
    KRD(GL,3); GAPB(o[1]=__builtin_amdgcn_mfma_f32_32x32x16_bf16(PAF(2),VFR(6),o[1],0,0,0), C1,4); \
    GAPB(o[0]=__builtin_amdgcn_mfma_f32_32x32x16_bf16(PAF(3),VFR(3),o[0],0,0,0), C1,8); \
    GAPB(o[1]=__builtin_amdgcn_mfma_f32_32x32x16_bf16(PAF(3),VFR(7),o[1],0,0,0), C1,12); \
    }while(0)
  int t=1;
  for(;t+5<NT;t+=2){
    STEP(pB0,pB1,pA0,pA1,t,true,true,true);     WAIT_BAR(2); RESC(); ROT();
    STEP(pA0,pA1,pB0,pB1,t+1,true,true,true);   WAIT_BAR(2); RESC(); ROT();
  }
  #define ENDW(tt) do{ if((tt)+3<NT){WAIT_BAR(2);} else if((tt)+2<NT){WAIT_BAR(1);} else {WAIT_BAR(0);} }while(0)
  for(;t+1<NT;t+=2){
    STEP(pB0,pB1,pA0,pA1,t,(t+3<NT),(t+1<NT),(t+1<NT));       ENDW(t);   RESC(); ROT();
    STEP(pA0,pA1,pB0,pB1,t+1,(t+4<NT),(t+2<NT),(t+2<NT));     ENDW(t+1); RESC(); ROT();
  }
  STEP(pB0,pB1,pA0,pA1,NT-1,false,false,false); RESC();
  { float sacc=pB0[0]+pB0[1]; _Pragma("unroll") for(int r=2;r<16;++r)sacc+=pB0[r]; _Pragma("unroll") for(int r=0;r<16;++r)sacc+=pB1[r]; l_reg+=sacc;
    pw0=(u32x4){PKW(pB0,0),PKW(pB0,2),PKW(pB0,4),PKW(pB0,6)};pw1=(u32x4){PKW(pB0,8),PKW(pB0,10),PKW(pB0,12),PKW(pB0,14)};pw2=(u32x4){PKW(pB1,0),PKW(pB1,2),PKW(pB1,4),PKW(pB1,6)};pw3=(u32x4){PKW(pB1,8),PKW(pB1,10),PKW(pB1,12),PKW(pB1,14)};
    SBAR(); pv(o,vb0+sl_cur,PAF(0),PAF(1),PAF(2),PAF(3)); }
  #undef PKW
  #undef PAF
  #undef VFR
  #undef PIN
  #undef MX3
  #undef GAPA
  #undef GAPB
  #undef EX
  #undef VRD
  #undef KRD
  #undef STEP
  #undef ENDW
  {auto rr=__builtin_amdgcn_permlane32_swap(__float_as_uint(l_reg),__float_as_uint(l_reg),false,false);l_reg=__uint_as_float(rr[0])+__uint_as_float(rr[1]);}
  if(hi==0)wsf[32+r32]=l_reg;asm volatile("s_waitcnt lgkmcnt(0)":::"memory");
  float rli[16];
  #pragma unroll
  for(int r=0;r<16;++r)rli[r]=__builtin_amdgcn_rcpf(wsf[32+crow(r,hi)]);
  const int slot_=valid_?(int)(((rowbase+s_)*NHEAD+h)*4+rank_):-1;
  if(hi==0){ ((int*)wsf)[r32]=slot_; if(valid_){ ML[2*(long)slot_]=mhat; ML[2*(long)slot_+1]=l_reg; } }
  { bf16*stg=(bf16*)(shm+LDS_OST)+wid*2048;
    #pragma unroll
    for(int r=0;r<16;++r){const int orow=crow(r,hi);
      #pragma unroll
      for(int d0=0;d0<2;++d0)stg[orow*64+d0*32+r32]=__float2bfloat16(o[d0][r]*rli[r]);}
    asm volatile("s_waitcnt lgkmcnt(0)":::"memory");
    #pragma unroll
    for(int i=0;i<4;++i){const int row=i*8+(lane>>3),ch=lane&7; const u32x4 v=*(const u32x4*)(stg+row*64+ch*8); const int sl_=((const int*)wsf)[row]; if(sl_>=0)ATTN_STORE16(PO+(long)sl_*64+ch*8,v);} }
  asm volatile("s_waitcnt lgkmcnt(0)\n\ts_barrier":::"memory");
  #undef DMA_K
  #undef DMA_V
  #undef CMASK
  #undef START
  #undef RESC
  #undef ROT
}
constexpr int ATTN_LDS_BYTES=LDS_BYTES;
#undef TSRC
#undef SBAR
#undef WAIT_BAR
}
constexpr int LD64 = 144, LD128 = 272;

DEV bf16x8 frag_row(const LAS unsigned char* base, int ld, int row0, int k0, int lane) { return *(const LAS bf16x8*)(base + (row0 + (lane & 31)) * ld + (k0 + 8 * (lane >> 5)) * 2); }
DEV bf16x8 frag_tr(const LAS unsigned char* base, int ld, int k0, int c0, int lane) {
    const LAS unsigned char* p = base + (k0 + 8 * (lane >> 5) + ((lane & 15) >> 2)) * ld + (c0 + 16 * ((lane >> 4) & 1) + 4 * (lane & 3)) * 2;
    const v4i16_t lo = __builtin_amdgcn_ds_read_tr16_b64_v4i16((LAS v4i16_t*)p); const v4i16_t hi = __builtin_amdgcn_ds_read_tr16_b64_v4i16((LAS v4i16_t*)(p + 4 * ld));
    return (bf16x8){lo[0], lo[1], lo[2], lo[3], hi[0], hi[1], hi[2], hi[3]};
}
template <int COLS>
DEV void stage_copy(LAS unsigned char* dst, int lld, const bf16_t* src, size_t gld, int rows, int tid) {
    constexpr int cpr = COLS / 8;
    for (int idx = tid; idx < rows * cpr; idx += NTHREADS) { const int r = idx / cpr, ch = idx % cpr; *(LAS v4u*)(dst + r * lld + ch * 16) = *(const v4u*)(src + (size_t)r * gld + ch * 8); }
}
struct Half { LAS unsigned char* L; int ht, hw, lane; };
DEV Half make_half(Frame& F) { Half H; H.L = F.lds + (F.wave >> 2) * 65536; H.ht = F.tid & 255; H.hw = F.wave & 3; H.lane = F.lane; return H; }
template <int COLS>
DEV void stage_copy_h(LAS unsigned char* dst, int lld, const bf16_t* src, size_t gld, int rows, int ht) {
    constexpr int cpr = COLS / 8;
    for (int idx = ht; idx < rows * cpr; idx += 256) { const int r = idx / cpr, ch = idx % cpr; *(LAS v4u*)(dst + r * lld + ch * 16) = *(const v4u*)(src + (size_t)r * gld + ch * 8); }
}
DEV void stage_load_h128(v4u (&v)[4], const bf16_t* src, size_t gld, int ht) {
#pragma unroll
    for (int i = 0; i < 4; ++i) { const int idx = ht + 256 * i, r = idx >> 4, ch = idx & 15; v[i] = *(const v4u*)(src + (size_t)r * gld + ch * 8); }
}
DEV void stage_store_h128(LAS unsigned char* dst, int lld, const v4u (&v)[4], int ht) {
#pragma unroll
    for (int i = 0; i < 4; ++i) { const int idx = ht + 256 * i, r = idx >> 4, ch = idx & 15; *(LAS v4u*)(dst + r * lld + ch * 16) = v[i]; }
}
#define LOADS_DONE() asm volatile("" ::: "memory")
DEV bf16x8 frag_row_g(const bf16_t* base, int ld, int row0, int k0, int lane) { return *(const bf16x8*)(base + (size_t)(row0 + (lane & 31)) * ld + k0 + 8 * (lane >> 5)); }
struct GlaCumIn { f32x4 gwv, gbv, z[4]; };
DEV void gla_cum_load(GlaCumIn& I, const Half& H, Frame& F, CArgs A, int l, size_t m0, int h) {
    const float* gw = A->in[6] + l * 16 * 256 + h * 64; const float* gb = A->in[7] + l * 256 + h * 64;
    { const int r = H.ht >> 4, c = (H.ht & 15) * 4; I.gwv = *(const f32x4*)(gw + r * 256 + c); }
    I.gbv = *(const f32x4*)(gb + (H.ht & 15) * 4);
    const float* ZS = (const float*)(F.ws + WS_ZS) + (m0 + H.lane) * 24;
#pragma unroll
    for (int q = 0; q < 4; ++q) I.z[q] = *(const f32x4*)(ZS + 4 * q);
}
DEV void gla_cum_h(const GlaCumIn& I, const Half& H, LAS float* CUM, LAS float* GWL) {
    { const int r = H.ht >> 4, c = (H.ht & 15) * 4; *(LAS f32x4*)(GWL + r * 64 + c) = I.gwv; }
    if (H.ht < 16) { const int c = H.ht * 4; *(LAS f32x4*)(GWL + 1024 + c) = I.gbv; }
    float z[16];
#pragma unroll
    for (int q = 0; q < 4; ++q) { z[4 * q] = I.z[q][0]; z[4 * q + 1] = I.z[q][1]; z[4 * q + 2] = I.z[q][2]; z[4 * q + 3] = I.z[q][3]; }
    __syncthreads();
#pragma unroll
    for (int t = 0; t < 16; ++t) { const int d = 16 * H.hw + t; float a = GWL[1024 + d];
#pragma unroll
        for (int r = 0; r < 16; ++r) a += z[r] * GWL[r * 64 + d];
        CUM[H.lane * 65 + d] = scan_add(logsigmoidf_(a) * (1.f / 16.f), H.lane); }
}
DEV void gla_local_h(const Half& H, Frame& F, CArgs A, int unit, int l) {
    const bf16_t* ZA = (const bf16_t*)(F.ws + WS_ZA); bf16_t* UG = (bf16_t*)(F.ws + WS_UG) + (size_t)unit * 128 * 64; float* DEC = (float*)(F.ws + WS_DEC) + unit * 64;
    const int bh = unit >> 7, c = unit & 127, b = bh >> 2, h = bh & 3; const size_t m0 = (size_t)b * SEQ + c * 64;
    LAS float* CUM = (LAS float*)H.L; LAS unsigned char* KE = H.L + 16640; LAS unsigned char* V = H.L + 25856; LAS float* GWL = (LAS float*)(H.L + 43264);
    v4u kk[2];
#pragma unroll
    for (int p = 0; p < 2; ++p) { const int it = H.ht + 256 * p; kk[p] = *(const v4u*)(ZA + (m0 + (it >> 3)) * ZA_LD + ZA_GK + h * 64 + (it & 7) * 8); }
    v4u vv[4]; stage_load_h128(vv, ZA + m0 * ZA_LD + ZA_GV + h * 128, ZA_LD, H.ht);
    GlaCumIn CI; gla_cum_load(CI, H, F, A, l, m0, h);
    LOADS_DONE();
    stage_store_h128(V, LD128, vv, H.ht);
    gla_cum_h(CI, H, CUM, GWL);
    __syncthreads();
#pragma unroll
    for (int p = 0; p < 2; ++p) { const int it = H.ht + 256 * p, tok = it >> 3, ch = it & 7; float f[8]; unpack8(kk[p], f);
#pragma unroll
        for (int i = 0; i < 8; ++i) f[i] *= __expf(CUM[63 * 65 + ch * 8 + i] - CUM[tok * 65 + ch * 8 + i]);
        *(LAS v4u*)(KE + tok * LD64 + ch * 16) = pack8(f); }
    if (H.ht < 64) DEC[H.ht] = __expf(CUM[63 * 65 + H.ht]);
    __syncthreads();
    { const int et = H.hw, r = H.lane & 31, hh = H.lane >> 5;
#pragma unroll
      for (int dt = 0; dt < 2; ++dt) { f32x16 acc = {};
#pragma unroll
          for (int k0 = 0; k0 < 64; k0 += 16) acc = MFMA32(frag_tr(V, LD128, k0, 32 * et, H.lane), frag_tr(KE, LD64, k0, 32 * dt, H.lane), acc);
#pragma unroll
          for (int g = 0; g < 16; ++g) UG[(32 * et + crow(g, hh)) * 64 + 32 * dt + r] = f2bf(acc[g]); } }
    __syncthreads();
}
DEV void mlstm_local_h(const Half& H, Frame& F, CArgs A, int unit, int l) {
    const bf16_t* ZA = (const bf16_t*)(F.ws + WS_ZA); const bf16_t* CQK = (const bf16_t*)(F.ws + WS_CQK2); const float* ZS = (const float*)(F.ws + WS_ZS);
    bf16_t* UG2 = (bf16_t*)(F.ws + WS_UG2) + (size_t)unit * 128 * 128; float* NU = (float*)(F.ws + WS_NU) + unit * 128;
    const int bh = unit >> 7, c = unit & 127, b = bh >> 2, h = bh & 3; const size_t m0 = (size_t)b * SEQ + c * 64;
    LAS unsigned char* KW = H.L + 1024; LAS unsigned char* V = H.L + 18432;
    v4u vvl[4]; float zs_f, zs_i;
    float kc[8][8];
    const int tg = H.ht >> 5, cc = H.ht & 31;
    { const int col = (cc < 16 ? ZA_LQ + h * 128 + cc * 8 : ZA_LK + h * 128 + (cc - 16) * 8), cch = (cc < 16 ? h * 128 + cc * 8 : 512 + h * 128 + (cc - 16) * 8);
      const int s0 = (int)(m0 & (SEQ - 1)) + 8 * tg; v4u rows[11]; stage_load_h128(vvl, ZA + m0 * ZA_LD + ZA_LV + h * 128, ZA_LD, H.ht); zs_f = ZS[(m0 + H.lane) * 24 + 20 + h]; zs_i = ZS[(m0 + H.lane) * 24 + 16 + h];
#pragma unroll
      for (int i = 0; i < 11; ++i) { const v4u zero = {0u, 0u, 0u, 0u}; rows[i] = (s0 - 3 + i >= 0) ? *(const v4u*)(ZA + (m0 + 8 * tg - 3 + i) * ZA_LD + col) : zero; }
      const float* cw = A->in[4] + l * 4 * 1024 + cch; const float* cb = A->in[5] + l * 1024 + cch; float wt[4][8], bb[8];
#pragma unroll
      for (int w = 0; w < 4; ++w) { const f32x4 t0 = *(const f32x4*)(cw + w * 1024), t1 = *(const f32x4*)(cw + w * 1024 + 4);
#pragma unroll
          for (int i = 0; i < 4; ++i) { wt[w][i] = t0[i]; wt[w][4 + i] = t1[i]; } }
      { const f32x4 t0 = *(const f32x4*)cb, t1 = *(const f32x4*)(cb + 4);
#pragma unroll
        for (int i = 0; i < 4; ++i) { bb[i] = t0[i]; bb[4 + i] = t1[i]; } }
      float fr[11][8];
#pragma unroll
      for (int i = 0; i < 11; ++i) unpack8(rows[i], fr[i]);
#pragma unroll
      for (int t = 0; t < 8; ++t) { float o[8];
#pragma unroll
          for (int i = 0; i < 8; ++i) o[i] = siluf_(bb[i] + fr[t][i] * wt[0][i] + fr[t + 1][i] * wt[1][i] + fr[t + 2][i] * wt[2][i] + fr[t + 3][i] * wt[3][i]);
          *(v4u*)(const_cast<bf16_t*>(CQK) + (m0 + 8 * tg + t) * 1024 + cch) = pack8(o);
#pragma unroll
          for (int i = 0; i < 8; ++i) kc[t][i] = bf2f(f2bf(o[i])); } }
    stage_store_h128(V, LD128, vvl, H.ht);
    const float fl = logsigmoidf_(zs_f); const float cum = scan_add(fl, H.lane); const float cl = __builtin_bit_cast(float, __builtin_amdgcn_readlane(__builtin_bit_cast(int, cum), 63));
    const float aa = cl - cum + zs_i; const float amax = wave_max(aa); const float w = __expf(aa - amax);
    if (H.ht == 0) { ((float*)(F.ws + WS_BL))[unit] = cl; ((float*)(F.ws + WS_AMAX))[unit] = amax; }
#pragma unroll
    for (int t = 0; t < 8; ++t) { const int tok = 8 * tg + t; const float wt = __shfl(w, tok) * 0.08838834764831845f; float f[8];
#pragma unroll
        for (int i = 0; i < 8; ++i) f[i] = kc[t][i] * wt;
        if (cc >= 16) *(LAS v4u*)(KW + tok * LD128 + (cc - 16) * 16) = pack8(f); }
    __syncthreads();
    { const int et = H.hw, r = H.lane & 31, hh = H.lane >> 5;
#pragma unroll
      for (int dt = 0; dt < 4; ++dt) { f32x16 acc = {};
#pragma unroll
          for (int k0 = 0; k0 < 64; k0 += 16) acc = MFMA32(frag_tr(V, LD128, k0, 32 * et, H.lane), frag_tr(KW, LD128, k0, 32 * dt, H.lane), acc);
#pragma unroll
          for (int g = 0; g < 16; ++g) UG2[(32 * et + crow(g, hh)) * 128 + 32 * dt + r] = f2bf(acc[g]); } }
    if (H.ht < 128) { float s = 0.f;
#pragma unroll 8
        for (int tok = 0; tok < 64; ++tok) s += bf2f(*(const LAS bf16_t*)(KW + tok * LD128 + H.ht * 2));
        NU[H.ht] = s; }
    __syncthreads();
}
DEV void gla_out_h(const Half& H, Frame& F, CArgs A, int unit, int l) {
    const bf16_t* ZA = (const bf16_t*)(F.ws + WS_ZA); const bf16_t* UG = (const bf16_t*)(F.ws + WS_UG) + (size_t)unit * 128 * 64; bf16_t* Y1 = (bf16_t*)(F.ws + WS_Y012) + (size_t)T * 512;
    const int bh = unit >> 7, c = unit & 127, b = bh >> 2, h = bh & 3; const size_t m0 = (size_t)b * SEQ + c * 64;
    LAS float* CUM = (LAS float*)H.L; LAS unsigned char* QD = H.L + 16640; LAS unsigned char* KI = H.L + 25856; LAS unsigned char* V = H.L + 35072; LAS unsigned char* ATT = H.L + 52480;
    LAS float* GWL = (LAS float*)(H.L + 52480);
    LAS float* O = (LAS float*)H.L;
    const int prow = H.ht >> 2, ppart = H.ht & 3;
    v4u rg[4]; { const v4u* rgp = (const v4u*)(ZA + (m0 + prow) * ZA_LD + ZA_GR + h * 128 + ppart * 32);
#pragma unroll
        for (int q = 0; q < 4; ++q) rg[q] = rgp[q]; }
    v4u q8[2], k8[2];
#pragma unroll
    for (int p = 0; p < 2; ++p) { const int it = H.ht + 256 * p; q8[p] = *(const v4u*)(ZA + (m0 + (it >> 3)) * ZA_LD + ZA_GQ + h * 64 + (it & 7) * 8); k8[p] = *(const v4u*)(ZA + (m0 + (it >> 3)) * ZA_LD + ZA_GK + h * 64 + (it & 7) * 8); }
    v4u vv[4]; stage_load_h128(vv, ZA + m0 * ZA_LD + ZA_GV + h * 128, ZA_LD, H.ht);
    GlaCumIn CI; gla_cum_load(CI, H, F, A, l, m0, h);
    bf16x8 ug[4];
#pragma unroll
    for (int k = 0; k < 4; ++k) ug[k] = frag_row_g(UG, 64, 32 * H.hw, 16 * k, H.lane);
    LOADS_DONE();
    stage_store_h128(V, LD128, vv, H.ht);
    gla_cum_h(CI, H, CUM, GWL);
    __syncthreads();
#pragma unroll
    for (int p = 0; p < 2; ++p) { const int it = H.ht + 256 * p, tok = it >> 3, ch = it & 7; float fq[8], fk[8]; unpack8(q8[p], fq); unpack8(k8[p], fk);
#pragma unroll
        for (int i = 0; i < 8; ++i) { const float cv = CUM[tok * 65 + ch * 8 + i]; fq[i] *= 0.125f * __expf(cv); fk[i] *= __expf(-cv); }
        *(LAS v4u*)(QD + tok * LD64 + ch * 16) = pack8(fq); *(LAS v4u*)(KI + tok * LD64 + ch * 16) = pack8(fk); }
    __syncthreads();
    const int r = H.lane & 31, hh = H.lane >> 5;
    { const int it = H.hw >> 1, jt = H.hw & 1; f32x16 acc = {};
      if (!(it == 0 && jt == 1)) {
#pragma unroll
          for (int k0 = 0; k0 < 64; k0 += 16) acc = MFMA32(frag_row(QD, LD64, 32 * it, k0, H.lane), frag_row(KI, LD64, 32 * jt, k0, H.lane), acc); }
#pragma unroll
      for (int g = 0; g < 16; ++g) { const int i = 32 * it + crow(g, hh), j = 32 * jt + r; *(LAS bf16_t*)(ATT + i * LD64 + j * 2) = f2bf(j <= i ? acc[g] : 0.f); } }
    __syncthreads();
    f32x16 oacc[2];
    { const int et = H.hw;
#pragma unroll
      for (int it = 0; it < 2; ++it) { f32x16 acc = {};
#pragma unroll
          for (int k0 = 0; k0 < 64; k0 += 16) acc = MFMA32(frag_row(ATT, LD64, 32 * it, k0, H.lane), frag_tr(V, LD128, k0, 32 * et, H.lane), acc);
#pragma unroll
          for (int k0 = 0; k0 < 64; k0 += 16) acc = MFMA32(frag_row(QD, LD64, 32 * it, k0, H.lane), ug[k0 >> 4], acc);
          oacc[it] = acc; } }
    __syncthreads();
#pragma unroll
    for (int it = 0; it < 2; ++it)
#pragma unroll
        for (int g = 0; g < 16; ++g) O[(32 * it + crow(g, hh)) * 132 + 32 * H.hw + r] = oacc[it][g];
    __syncthreads();
    { const float* gn = A->in[8] + l * 512 + h * 128 + ppart * 32; float x[32]; float ss = 0.f;
#pragma unroll
      for (int q = 0; q < 8; ++q) { const f32x4 t = *(const LAS f32x4*)(O + prow * 132 + ppart * 32 + 4 * q); x[4 * q] = t[0]; x[4 * q + 1] = t[1]; x[4 * q + 2] = t[2]; x[4 * q + 3] = t[3]; ss += t[0] * t[0] + t[1] * t[1] + t[2] * t[2] + t[3] * t[3]; }
      ss += __shfl_xor(ss, 1); ss += __shfl_xor(ss, 2);
      const float sc = rsqrtf(ss * (1.f / 128.f) + EPS); v4u* yp = (v4u*)(Y1 + (m0 + prow) * 512 + h * 128 + ppart * 32);
#pragma unroll
      for (int q = 0; q < 4; ++q) { float gt[8], y[8]; unpack8(rg[q], gt); const f32x4 g0 = *(const f32x4*)(gn + 8 * q), g1 = *(const f32x4*)(gn + 8 * q + 4);
#pragma unroll
          for (int i = 0; i < 4; ++i) { y[i] = x[8 * q + i] * sc * g0[i] * siluf_(gt[i]); y[4 + i] = x[8 * q + 4 + i] * sc * g1[i] * siluf_(gt[4 + i]); }
          yp[q] = pack8(y); } }
    __syncthreads();
}
DEV void mlstm_out_h(const Half& H, Frame& F, int unit) {
    const bf16_t* ZA = (const bf16_t*)(F.ws + WS_ZA); const bf16_t* CQK = (const bf16_t*)(F.ws + WS_CQK2); const float* ZS = (const float*)(F.ws + WS_ZS);
    const bf16_t* UG2 = (const bf16_t*)(F.ws + WS_UG2) + (size_t)unit * 128 * 128; const float* NP = (const float*)(F.ws + WS_NU) + unit * 128; bf16_t* Y2 = (bf16_t*)(F.ws + WS_Y012) + (size_t)2 * T * 512;
    const int bh = unit >> 7, c = unit & 127, b = bh >> 2, h = bh & 3; const size_t m0 = (size_t)b * SEQ + c * 64;
    LAS float* AR = (LAS float*)H.L;
    LAS unsigned char* Q = H.L + 2048; LAS unsigned char* K = H.L + 19456; LAS unsigned char* V = H.L + 36864; LAS unsigned char* WI = H.L + 54272;
    LAS float* O = (LAS float*)(H.L + 2048);
    const int prow = H.ht >> 2, ppart = H.ht & 3;
    v4u og[4]; { const v4u* ogp = (const v4u*)(ZA + (m0 + prow) * ZA_LD + ZA_LO + h * 128 + ppart * 32);
#pragma unroll
        for (int q = 0; q < 4; ++q) og[q] = ogp[q]; }
    f32x4 npv = {0.f, 0.f, 0.f, 0.f}; if (H.ht < 32) npv = *(const f32x4*)(NP + 4 * H.ht);
    v4u kk[4];
#pragma unroll
    for (int p = 0; p < 4; ++p) { const int tok = (H.ht >> 4) + 16 * p, ch = H.ht & 15; kk[p] = *(const v4u*)(CQK + (m0 + tok) * 1024 + 512 + h * 128 + ch * 8); }
    v4u vq[4], vv[4]; stage_load_h128(vq, CQK + m0 * 1024 + h * 128, 1024, H.ht); stage_load_h128(vv, ZA + m0 * ZA_LD + ZA_LV + h * 128, ZA_LD, H.ht);
    const float zs_f = ZS[(m0 + H.lane) * 24 + 20 + h], zs_i = ZS[(m0 + H.lane) * 24 + 16 + h], mp = ((const float*)(F.ws + WS_MPREV))[unit];
    bf16x8 ug[8];
#pragma unroll
    for (int k = 0; k < 8; ++k) ug[k] = frag_row_g(UG2, 128, 32 * H.hw, 16 * k, H.lane);
    LOADS_DONE();
    stage_store_h128(Q, LD128, vq, H.ht); stage_store_h128(V, LD128, vv, H.ht); if (H.ht < 32) *(LAS f32x4*)(AR + 384 + 4 * H.ht) = npv;
    if (H.hw == 0) { const float fl = logsigmoidf_(zs_f); const float cum = scan_add(fl, H.lane); const float g = zs_i - cum;
        const float pm = scan_max(g, H.lane); const float mx = fmaxf(mp, pm);
        AR[H.lane] = cum; AR[64 + H.lane] = g; AR[128 + H.lane] = mx; AR[192 + H.lane] = __expf(mp - mx); }
#pragma unroll
    for (int p = 0; p < 4; ++p) { const int tok = (H.ht >> 4) + 16 * p, ch = H.ht & 15; float f[8]; unpack8(kk[p], f);
#pragma unroll
        for (int i = 0; i < 8; ++i) f[i] *= 0.08838834764831845f;
        *(LAS v4u*)(K + tok * LD128 + ch * 16) = pack8(f); }
    __syncthreads();
    const int r = H.lane & 31, hh = H.lane >> 5;
    { const int it = H.hw >> 1, jt = H.hw & 1; f32x16 acc = {};
      if (!(it == 0 && jt == 1)) {
#pragma unroll
          for (int k0 = 0; k0 < 128; k0 += 16) acc = MFMA32(frag_row(Q, LD128, 32 * it, k0, H.lane), frag_row(K, LD128, 32 * jt, k0, H.lane), acc); }
      const int j = 32 * jt + r; const float gj = AR[64 + j];
#pragma unroll
      for (int g = 0; g < 16; ++g) { const int i = 32 * it + crow(g, hh); *(LAS bf16_t*)(WI + i * LD64 + j * 2) = f2bf(j <= i ? acc[g] * __expf(gj - AR[128 + i]) : 0.f); } }
    { float a = 0.f;
#pragma unroll
      for (int q = 0; q < 4; ++q) { float f[8]; unpack8(*(const LAS v4u*)(Q + prow * LD128 + ppart * 64 + q * 16), f); const f32x4 n0 = *(const LAS f32x4*)(AR + 384 + ppart * 32 + q * 8), n1 = *(const LAS f32x4*)(AR + 384 + ppart * 32 + q * 8 + 4);
          a += f[0] * n0[0] + f[1] * n0[1] + f[2] * n0[2] + f[3] * n0[3] + f[4] * n1[0] + f[5] * n1[1] + f[6] * n1[2] + f[7] * n1[3]; }
      a += __shfl_xor(a, 1); a += __shfl_xor(a, 2); if (ppart == 0) AR[256 + prow] = a; }
    __syncthreads();
    { float sw = 0.f;
#pragma unroll
      for (int q = 0; q < 2; ++q) { float f[8]; unpack8(*(const LAS v4u*)(WI + prow * LD64 + ppart * 32 + q * 16), f); sw += ((f[0] + f[1]) + (f[2] + f[3])) + ((f[4] + f[5]) + (f[6] + f[7])); }
      sw += __shfl_xor(sw, 1); sw += __shfl_xor(sw, 2);
      if (ppart == 0) { const float den = AR[192 + prow] * AR[256 + prow] + sw; AR[320 + prow] = __builtin_amdgcn_rcpf(fmaxf(fabsf(den), __expf(-(AR[prow] + AR[128 + prow])))); } }
    f32x16 oacc[2];
    { const int et = H.hw;
#pragma unroll
      for (int it = 0; it < 2; ++it) { f32x16 acc = {};
#pragma unroll
          for (int k0 = 0; k0 < 128; k0 += 16) acc = MFMA32(frag_row(Q, LD128, 32 * it, k0, H.lane), ug[k0 >> 4], acc);
#pragma unroll
          for (int g = 0; g < 16; ++g) acc[g] *= AR[192 + 32 * it + crow(g, hh)];
#pragma unroll
          for (int k0 = 0; k0 < 64; k0 += 16) acc = MFMA32(frag_row(WI, LD64, 32 * it, k0, H.lane), frag_tr(V, LD128, k0, 32 * et, H.lane), acc);
          oacc[it] = acc; } }
    __syncthreads();
#pragma unroll
    for (int it = 0; it < 2; ++it)
#pragma unroll
        for (int g = 0; g < 16; ++g) O[(32 * it + crow(g, hh)) * 132 + 32 * H.hw + r] = oacc[it][g];
    __syncthreads();
    { const float rd = AR[320 + prow]; v4u* yp = (v4u*)(Y2 + (m0 + prow) * 512 + h * 128 + ppart * 32);
#pragma unroll
      for (int q = 0; q < 4; ++q) { float gt[8], y[8]; unpack8(og[q], gt); const f32x4 t0 = *(const LAS f32x4*)(O + prow * 132 + ppart * 32 + 8 * q), t1 = *(const LAS f32x4*)(O + prow * 132 + ppart * 32 + 8 * q + 4);
#pragma unroll
          for (int i = 0; i < 4; ++i) { y[i] = t0[i] * rd * sigmoidf_(gt[i]); y[4 + i] = t1[i] * rd * sigmoidf_(gt[4 + i]); }
          yp[q] = pack8(y); } }
    __syncthreads();
}
DEV void p_mixer_scan(Frame& F) {
    const int gt = F.vcu * NTHREADS + F.tid;
    if (gt < 32768) {
        const int bh = gt >> 12, e = (gt >> 5) & 127, dp = gt & 31; unsigned* U = (unsigned*)(F.ws + WS_UG) + ((size_t)bh * 128 * 128 + e) * 32 + dp; const float* DEC = (const float*)(F.ws + WS_DEC) + bh * 128 * 64 + 2 * dp;
        float s0 = 0.f, s1 = 0.f;
        for (int c0 = 0; c0 < 128; c0 += 16) { unsigned u[16]; float2 dd[16];
#pragma unroll
            for (int i = 0; i < 16; ++i) { u[i] = U[(size_t)(c0 + i) * 128 * 32]; dd[i] = *(const float2*)(DEC + (c0 + i) * 64); }
#pragma unroll
            for (int i = 0; i < 16; ++i) { U[(size_t)(c0 + i) * 128 * 32] = pk2(s0, s1); s0 = dd[i].x * s0 + __uint_as_float(u[i] << 16); s1 = dd[i].y * s1 + __uint_as_float(u[i] & 0xffff0000u); } }
    } else if (gt < 32768 + 65536) {
        const int q = gt - 32768, bh = q >> 13, e = (q >> 6) & 127, dp = q & 63; unsigned* U = (unsigned*)(F.ws + WS_UG2) + ((size_t)bh * 128 * 128 + e) * 64 + dp;
        float* NU = (float*)(F.ws + WS_NU) + (size_t)bh * 128 * 128 + 2 * dp; const float* BL = (const float*)(F.ws + WS_BL) + bh * 128; const float* AM = (const float*)(F.ws + WS_AMAX) + bh * 128; float* MP = (float*)(F.ws + WS_MPREV) + bh * 128;
        float s0 = 0.f, s1 = 0.f, n0 = 0.f, n1 = 0.f, m = 0.f;
        for (int c0 = 0; c0 < 128; c0 += 16) { unsigned u[16]; float bl[16], am[16]; float2 nu[16];
#pragma unroll
            for (int i = 0; i < 16; ++i) { u[i] = U[(size_t)(c0 + i) * 128 * 64]; bl[i] = BL[c0 + i]; am[i] = AM[c0 + i]; nu[i] = (e == 0) ? *(const float2*)(NU + (c0 + i) * 128) : make_float2(0.f, 0.f); }
#pragma unroll
            for (int i = 0; i < 16; ++i) { const int c = c0 + i; const float mn = fmaxf(bl[i] + m, am[i]), a = __expf(bl[i] + m - mn), bb = __expf(am[i] - mn);
                U[(size_t)c * 128 * 64] = pk2(s0, s1);
                if (e == 0) { *(float2*)(NU + c * 128) = make_float2(n0, n1); n0 = a * n0 + bb * nu[i].x; n1 = a * n1 + bb * nu[i].y; if (dp == 0) MP[c] = m; }
                s0 = a * s0 + bb * __uint_as_float(u[i] << 16); s1 = a * s1 + bb * __uint_as_float(u[i] & 0xffff0000u); m = mn; } }
    }
}


constexpr size_t WS_PO = 105 * MiB;
constexpr size_t WS_ML = 169 * MiB;
constexpr size_t WS_LIST = 186 * MiB;
constexpr int CW_MCNT = 8192;
DEV void p_moba_select(Frame& F, int l) {
    const bf16_t* ZA = (const bf16_t*)(F.ws + WS_ZA); const float* KM = (const float*)(F.ws + WS_KM); unsigned* cnt = (unsigned*)(F.ws + WS_CTL) + CW_MCNT + l * 512; unsigned short* lists = (unsigned short*)(F.ws + WS_LIST);
    LAS float* kmL = (LAS float*)(F.lds + 65536);
    for (int w = F.gw; w < 2048; w += F.NGW) { const int bh = w >> 7, qb = (w >> 2) & 31, s = qb * 256 + (w & 3) * 64 + F.lane, b = bh >> 3, h = bh & 7;
        __syncthreads(); ((LAS f32x4*)kmL)[F.tid] = ((const f32x4*)(KM + (size_t)bh * 2048))[F.tid]; __syncthreads();
        if (qb == 0) continue;
        int i0 = 0, i1 = 1, i2 = 2;
        if (qb > 3) { float q[64]; const v4u* qp = (const v4u*)(ZA + ((size_t)b * SEQ + s) * ZA_LD + ZA_MQ + h * 64);
#pragma unroll
            for (int c = 0; c < 8; ++c) { float f[8]; unpack8(qp[c], f);
#pragma unroll
                for (int i = 0; i < 8; ++i) q[c * 8 + i] = f[i]; }
            { const float* cs = (const float*)(F.ws + WS_ROPE_COS) + s * 8; const float* sn = (const float*)(F.ws + WS_ROPE_SIN) + s * 8;
#pragma unroll
              for (int d = 0; d < 8; ++d) { const float x1 = q[d], x2 = q[8 + d], c = cs[d], sv = sn[d]; q[d] = x1 * c - x2 * sv; q[8 + d] = x2 * c + x1 * sv; } }
            float b0 = -INFINITY, b1 = -INFINITY, b2 = -INFINITY;
            for (int j = 0; j < qb; ++j) { float a = 0.f;
#pragma unroll
                for (int d4 = 0; d4 < 16; ++d4) { const f32x4 kv = ((const LAS f32x4*)(kmL + j * 64))[d4]; a += q[4 * d4] * kv[0] + q[4 * d4 + 1] * kv[1] + q[4 * d4 + 2] * kv[2] + q[4 * d4 + 3] * kv[3]; }
                const bool g0 = a > b0, g1 = a > b1, g2 = a > b2;
                i2 = g1 ? i1 : (g2 ? j : i2); b2 = g1 ? b1 : (g2 ? a : b2);
                i1 = g0 ? i0 : (g1 ? j : i1); b1 = g0 ? b0 : (g1 ? a : b1);
                i0 = g0 ? j : i0; b0 = g0 ? a : b0; } }
        const int nsel = qb < 3 ? qb : 3; const unsigned long long lt = (1ull << F.lane) - 1ull;
        unsigned mytot = 0u; int off0 = 0, off1 = 0, off2 = 0;
        for (int jj = 0; jj < qb; ++jj) { const bool p0 = nsel > 0 && i0 == jj, p1 = nsel > 1 && i1 == jj, p2 = nsel > 2 && i2 == jj;
            const unsigned long long m0 = __ballot(p0), m1 = __ballot(p1), m2 = __ballot(p2); const int c0 = __popcll(m0), c1 = __popcll(m1);
            const unsigned tot = (unsigned)(c0 + c1 + __popcll(m2)); mytot = (F.lane == jj) ? tot : mytot;
            off0 = p0 ? __popcll(m0 & lt) : off0; off1 = p1 ? c0 + __popcll(m1 & lt) : off1; off2 = p2 ? c0 + c1 + __popcll(m2 & lt) : off2; }
        unsigned mybase = 0u; if (F.lane < qb && mytot > 0u) mybase = __hip_atomic_fetch_add(cnt + bh * 32 + F.lane, mytot, __ATOMIC_RELAXED, __HIP_MEMORY_SCOPE_AGENT);
        const unsigned b0 = (unsigned)__shfl((int)mybase, i0), b1 = (unsigned)__shfl((int)mybase, i1), b2 = (unsigned)__shfl((int)mybase, i2);
        if (nsel > 0) lists[(size_t)(bh * 32 + i0) * 8192 + b0 + off0] = (unsigned short)s;
        if (nsel > 1) lists[(size_t)(bh * 32 + i1) * 8192 + b1 + off1] = (unsigned short)(s | (1 << 13));
        if (nsel > 2) lists[(size_t)(bh * 32 + i2) * 8192 + b2 + off2] = (unsigned short)(s | (2 << 13));
    }
}
DEV void p_moba_sparse(Frame& F, int l) {
    const attn_body::bf16* ZAb = (const attn_body::bf16*)(F.ws + WS_ZA); attn_body::bf16* PO = (attn_body::bf16*)(F.ws + WS_PO); float* ML = (float*)(F.ws + WS_ML);
    const unsigned* cnt = (const unsigned*)(F.ws + WS_CTL) + CW_MCNT + l * 512; const unsigned short* lists = (const unsigned short*)(F.ws + WS_LIST);
    LAS int* pre = (LAS int*)(F.lds + 98304);
    const float* rcs = (const float*)(F.ws + WS_ROPE_COS); const float* rsn = (const float*)(F.ws + WS_ROPE_SIN);
    if (F.wave == 0) { int v[8]; int sum = 0;
#pragma unroll
        for (int i = 0; i < 8; ++i) { v[i] = sum; sum += (int)((cnt[8 * F.lane + i] + 255u) >> 8); }
        const int excl = (int)scan_add((float)sum, F.lane) - sum;
#pragma unroll
        for (int i = 0; i < 8; ++i) pre[8 * F.lane + i] = excl + v[i];
        if (F.lane == 63) pre[512] = excl + sum; }
    __syncthreads();
    const int U = 512 + pre[512];
    for (int k = F.vcu; k < U; k += F.G) {
        if (k < 512) { const int bh = k >> 5, j = k & 31; attn_body::attn_unit<8, true>(F.tid, bh >> 3, bh & 7, j, nullptr, 0, 0, ZAb + ZA_MQ, ZAb + ZA_MK, ZAb + ZA_MV, PO, ML, rcs, rsn, (char*)F.ldsg); }
        else { const int p = k - 512; int lo = 0, hi = 512; while (hi - lo > 1) { const int mid = (lo + hi) >> 1; if (pre[mid] <= p) lo = mid; else hi = mid; }
            const int t = lo, bh = t >> 5, j = t & 31; attn_body::attn_unit<8, false>(F.tid, bh >> 3, bh & 7, j, lists + (size_t)t * 8192, p - pre[t], (int)cnt[t], ZAb + ZA_MQ, ZAb + ZA_MK, ZAb + ZA_MV, PO, ML, rcs, rsn, (char*)F.ldsg); }
    }
}
DEV void p_moba_combine(Frame& F) {
    const bf16_t* PO = (const bf16_t*)(F.ws + WS_PO); const float* ML = (const float*)(F.ws + WS_ML); bf16_t* Y0 = (bf16_t*)(F.ws + WS_Y012);
    const int NTc = F.G * NTHREADS;
    for (int idx0 = F.vcu * NTHREADS + F.tid; idx0 < T * 64; idx0 += 2 * NTc) { float mm[2][4], ll[2][4]; v4u ov[2][4];
#pragma unroll
        for (int u = 0; u < 2; ++u) { const int idx = idx0 + u * NTc, ch = idx & 7, mh = idx >> 3, m = mh >> 3, qb = (m & (SEQ - 1)) >> 8, nsel = qb < 3 ? qb : 3;
#pragma unroll
            for (int r = 0; r < 4; ++r) { const bool on = idx < T * 64 && ((r == 3) || (r < nsel)); const size_t sl = (size_t)mh * 4 + r; typedef float f32x2n __attribute__((ext_vector_type(2))); const f32x2n t = on ? __builtin_nontemporal_load((const f32x2n*)(ML + 2 * sl)) : (f32x2n){-INFINITY, 0.f}; mm[u][r] = t.x; ll[u][r] = t.y;
                const v4u z = {0u, 0u, 0u, 0u}; ov[u][r] = on ? __builtin_nontemporal_load((const v4u*)(PO + sl * 64 + ch * 8)) : z; } }
#pragma unroll
        for (int u = 0; u < 2; ++u) { const int idx = idx0 + u * NTc, ch = idx & 7, mh = idx >> 3; if (idx >= T * 64) break;
            const float M = fmaxf(fmaxf(mm[u][0], mm[u][1]), fmaxf(mm[u][2], mm[u][3])); float wsum = 0.f, acc[8];
#pragma unroll
            for (int i = 0; i < 8; ++i) acc[i] = 0.f;
#pragma unroll
            for (int r = 0; r < 4; ++r) { const float w = ll[u][r] * __builtin_amdgcn_exp2f(mm[u][r] - M); wsum += w; float f[8]; unpack8(ov[u][r], f);
#pragma unroll
                for (int i = 0; i < 8; ++i) acc[i] += w * f[i]; }
            const float inv = __builtin_amdgcn_rcpf(wsum);
#pragma unroll
            for (int i = 0; i < 8; ++i) acc[i] *= inv;
            *(v4u*)(Y0 + (size_t)mh * 64 + ch * 8) = pack8(acc); } }
}

constexpr int N_PHASES = 26;
#ifndef REPEAT_MASK
#define REPEAT_MASK 0u
#endif
__global__ void __launch_bounds__(NTHREADS, 2) fwd(const Args A_) {
    extern __shared__ __attribute__((aligned(16))) unsigned char lds[];
    volatile LAS unsigned* MISC = (volatile LAS unsigned*)((LAS unsigned char*)lds + MISC_OFF);
    for (int u = threadIdx.x; u < (LDS_BYTES - LDSCTL_OFF) / 4; u += NTHREADS) ((LAS unsigned*)((LAS unsigned char*)lds + LDSCTL_OFF))[u] = 0u;
    __syncthreads();
    XcdBarrier bar = xcd_barrier_post((unsigned*)(A_.ws + WS_CTL) + CW_BAR, MISC + 8);
    const int lo = A_.ph_lo, hi = A_.ph_hi; int ph = 0;
    const unsigned wave_id_ = __builtin_amdgcn_readfirstlane(threadIdx.x >> 6);
#define PHASE_BEGIN if (lo <= ph && ph < hi) { const int nrep_ = 1 + (int)((REPEAT_MASK >> ph) & 1u); for (int rep_ = 0; rep_ < nrep_; ++rep_) { Frame F; CArgs A; { unsigned wv_ = wave_id_; asm volatile("" : "+s"(wv_)); unsigned t_ = (wv_ << 6) | __builtin_amdgcn_mbcnt_hi(~0u, __builtin_amdgcn_mbcnt_lo(~0u, 0u)); asm volatile("" : "+v"(t_)); unsigned bx_ = blockIdx.x; asm volatile("" : "+s"(bx_)); \
        unsigned long long ka_ = (unsigned long long)__builtin_amdgcn_kernarg_segment_ptr(); asm volatile("" : "+s"(ka_)); A = (CArgs)ka_; \
        F.lds = (LAS unsigned char*)lds; F.ldsg = lds; F.tid = (int)t_; F.lane = F.tid & 63; F.wave = __builtin_amdgcn_readfirstlane(F.tid >> 6); F.G = gridDim.x; F.bx = (int)bx_; \
        F.vcu = (F.G % 8 == 0) ? (F.bx % 8) * (F.G / 8) + F.bx / 8 : F.bx; F.gw = F.vcu * NWAVES + F.wave; F.NGW = F.G * NWAVES; unsigned long long z_ = 0ull; asm volatile("" : "+s"(z_)); F.X = A_.out + z_; F.ws = A_.ws + z_; } \
        unsigned char* ws = F.ws; bf16_t* XN = (bf16_t*)(ws + WS_XN); bf16_t* ZA = (bf16_t*)(ws + WS_ZA); bf16_t* ZG = (bf16_t*)(ws + WS_ZG); float* ZS = (float*)(ws + WS_ZS); \
        bf16_t* Y012 = (bf16_t*)(ws + WS_Y012); bf16_t* U = (bf16_t*)(ws + WS_U); bf16_t* HD = (bf16_t*)(ws + WS_HD); (void)XN; (void)ZA; (void)ZG; (void)ZS; (void)Y012; (void)U; (void)HD;
#define REFRAME() do { asm volatile("" : "+v"(F.tid)); F.lane = F.tid & 63; F.wave = __builtin_amdgcn_readfirstlane(F.tid >> 6); asm volatile("" : "+s"(F.vcu)); F.gw = F.vcu * NWAVES + F.wave; \
        unsigned long long z2_ = 0ull; asm volatile("" : "+s"(z2_)); F.ws = F.ws + z2_; } while (0)
#define PHASE_END   if (ph + 1 < hi || rep_ + 1 < nrep_) { XcdBarrier b_ = bar; asm volatile("" : "+s"(b_.x)); unsigned long long p_ = (unsigned long long)b_.bar; asm volatile("" : "+s"(p_)); b_.bar = (unsigned*)p_; xcd_barrier(b_); } } } ++ph;

    PHASE_BEGIN
        p_rope_table(F); p_sample_moe_amax(F, A); p_prep_small_weights(F, A, 0); __syncthreads();
        p_norm<24>(F, A->in[0], A->in[1], XN, A->in[2], NIN, 2560, 4624, A->in[3], ZS, nullptr, nullptr);
    PHASE_END
    { constexpr int l = 0;
        if (l == 1) {
            PHASE_BEGIN
                p_norm<24, true>(F, (const float*)(ws + WS_XB), A->in[1] + D, XN, A->in[2] + (size_t)D * NIN, NIN, 2560, 4624, A->in[3] + NIN, ZS, nullptr, nullptr);
            PHASE_END
        }
        PHASE_BEGIN
            pg8::Sched S; S.init(T / 256, 20, F.G, F.bx, XN, D, (bf16_t*)(ws + WS_WIN) + (size_t)l * 8192 * 1024, D);
            pg8::EpiInproj E{ZA, ZG, A->in[3] + l * NIN, ws};
            pg8::gemm_phase<pg8::EpiInproj, pg8::Sched, true, true>(F.lds, F.tid, D, D, D, S, E);
        PHASE_END
        PHASE_BEGIN
            p_mixer_prep(F, A, l);
            REFRAME();
            { const Half H = make_half(F); for (int u = F.vcu + (F.wave >> 2) * F.G; u < 1024; u += 2 * F.G) gla_local_h(H, F, A, u, l); }
            REFRAME();
            { const Half H = make_half(F); for (int u = F.vcu + (F.wave >> 2) * F.G; u < 1024; u += 2 * F.G) mlstm_local_h(H, F, A, u, l); }
        PHASE_END
        PHASE_BEGIN
            if (l == 0) p_prep_l0_late(F, A);
            REFRAME();
            p_mixer_scan(F);
            REFRAME();
            p_moba_select(F, l);
        PHASE_END
        PHASE_BEGIN
            { const Half H = make_half(F); for (int u = F.vcu + (F.wave >> 2) * F.G; u < 1024; u += 2 * F.G) gla_out_h(H, F, A, u, l); }
            REFRAME();
            { const Half H = make_half(F); for (int u = F.vcu + (F.wave >> 2) * F.G; u < 1024; u += 2 * F.G) mlstm_out_h(H, F, u); }
        PHASE_END
        PHASE_BEGIN
            p_moba_sparse(F, l);
        PHASE_END
        PHASE_BEGIN
            p_moba_combine(F);
            REFRAME();
            pg8::Sched S; S.init(T / 256, 12, F.G, F.bx, XN, D, (bf16_t*)(ws + WS_WIN) + (size_t)l * 8192 * 1024, D); S.pn0 = 20;
            pg8::EpiInproj E{ZA, ZG, A->in[3] + l * NIN, ws};
            pg8::gemm_phase<pg8::EpiInproj, pg8::Sched, true, true>(F.lds, F.tid, D, D, D, S, E);
        PHASE_END
        PHASE_BEGIN
            pg8::Sched S; S.init(T / 256, 4, F.G, F.bx, Y012, 512, (bf16_t*)(ws + WS_WUP) + (size_t)l * 3072 * 512, 512); S.a_split_tiles = 4; S.a_split_bytes = (size_t)T * 512 * 2; S.branch3 = 1;
            pg8::EpiUpGate E{U, ZG};
            pg8::gemm_phase<pg8::EpiUpGate, pg8::Sched, true, true>(F.lds, F.tid, 512, 512, 512, S, E);
        PHASE_END
        PHASE_BEGIN
            pg8::Sched S; S.init(T / 256, D / 256, F.G, F.bx, U, D, (bf16_t*)(ws + WS_WO3) + (size_t)l * 1024 * 1024, D);
            if (l == 0) { pg8::EpiResidT<false, true> E{A->in[0], ws + WS_XB}; pg8::gemm_phase<pg8::EpiResidT<false, true>, pg8::Sched, true, true>(F.lds, F.tid, D, D, D, S, E); }
            else { pg8::EpiResidT<true, true> E{ws + WS_XB, ws + WS_XB}; pg8::gemm_phase<pg8::EpiResidT<true, true>, pg8::Sched, true, true>(F.lds, F.tid, D, D, D, S, E); }
        PHASE_END
        if (l == 0) {
            PHASE_BEGIN
                p_prep_small_weights(F, A, 1);
                p_norm<0, true>(F, (const float*)(ws + WS_XB), A->in[13], XN, nullptr, 0, 0, 0, nullptr, nullptr, nullptr, nullptr);
            PHASE_END
            PHASE_BEGIN
                pg8::EpiSwiglu E{HD}; const int units = (T / 256) * 22, R = units / F.G, Lc = units - R * F.G; const bool hs = Lc > 0 && 2 * Lc <= F.G && R > 0;
                { pg8::Sched S; S.init(T / 256, 5632 / 256, F.G, F.bx, XN, D, ws + WS_WFGU, D); if (hs) S.lim = R * F.G;
                  pg8::gemm_phase<pg8::EpiSwiglu, pg8::Sched, true, true>(F.lds, F.tid, D, D, D, S, E); }
                if (hs) { pg8::Sched S; S.init(T / 256, 5632 / 256, F.G, F.bx, XN, D, ws + WS_WFGU, D); S.first = R * F.G; S.nhalf = Lc;
                  pg8::gemm_phase<pg8::EpiSwiglu, pg8::Sched, true, true, true>(F.lds, F.tid, D, D, D, S, E); }
            PHASE_END
            PHASE_BEGIN
                pg8::Sched S; S.init(T / 256, D / 256, F.G, F.bx, HD, DFF, ws + WS_WFD, DFF);
                pg8::EpiResidT<true, true> E{ws + WS_XB, ws + WS_XB};
                pg8::gemm_phase<pg8::EpiResidT<true, true>, pg8::Sched, true, true>(F.lds, F.tid, DFF, DFF, DFF, S, E);
            PHASE_END
        } else {
            PHASE_BEGIN
                p_prep_moe_weights(F, A); __syncthreads();
                p_norm<8, true, true>(F, (const float*)(ws + WS_XB), A->in[13] + D, (bf16_t*)(ws + WS_XN2), A->in[17], 8, 0, 0, A->in[18], nullptr, (int*)(ws + WS_TOPE), (float*)(ws + WS_TOPG));
            PHASE_END
            PHASE_BEGIN
                p_route_gather(F);
            PHASE_END
            PHASE_BEGIN
                const int nb = *(const int*)(ws + WS_NBLK);
                const float* wam = (const float*)(ws + WS_CTL) + CW_WAMAX;
                pg8::EpiSwigluQ E{(bf16_t*)(ws + WS_HM), (const float*)(ws + WS_RSG), 1.f / pow2_scale(wam[0]), 1.f / pow2_scale(wam[64])}; const int units = nb * 22, R = units / F.G, Lc = units - R * F.G; const bool hs = Lc > 0 && 2 * Lc <= F.G && R > 0;
                { pg8::Sched S; S.init(nb, 5632 / 256, F.G, F.bx, ws + WS_YM, D / 2, ws + WS_MGU, D / 2); S.blk_e = (const int*)(ws + WS_BLK_E); S.b_estride = (size_t)5632 * 1024; if (hs) S.lim = R * F.G;
                  pg8::gemm_phase<pg8::EpiSwigluQ, pg8::Sched, true, true, false, 1>(F.lds, F.tid, D / 2, D / 2, D / 2, S, E); }
                if (hs) { pg8::Sched S; S.init(nb, 5632 / 256, F.G, F.bx, ws + WS_YM, D / 2, ws + WS_MGU, D / 2); S.blk_e = (const int*)(ws + WS_BLK_E); S.b_estride = (size_t)5632 * 1024; S.first = R * F.G; S.nhalf = Lc;
                  pg8::gemm_phase<pg8::EpiSwigluQ, pg8::Sched, true, true, true, 1>(F.lds, F.tid, D / 2, D / 2, D / 2, S, E); }
            PHASE_END
            PHASE_BEGIN
                const int nb = *(const int*)(ws + WS_NBLK);
                const float* wam = (const float*)(ws + WS_CTL) + CW_WAMAX;
                pg8::EpiStoreQ E{(bf16_t*)(ws + WS_YM), 1.f / pow2_scale(wam[128])}; const int units = nb * 4, R = units / F.G, Lc = units - R * F.G; const bool hs = Lc > 0 && 2 * Lc <= F.G && R > 0;
                { pg8::Sched S; S.init(nb, D / 256, F.G, F.bx, ws + WS_HM, DFF / 2, ws + WS_MD, DFF / 2); S.blk_e = (const int*)(ws + WS_BLK_E); S.b_estride = (size_t)1024 * DFF; if (hs) S.lim = R * F.G;
                  pg8::gemm_phase<pg8::EpiStoreQ, pg8::Sched, true, true, false, 2>(F.lds, F.tid, DFF / 2, DFF / 2, DFF / 2, S, E); }
                if (hs) { pg8::Sched S; S.init(nb, D / 256, F.G, F.bx, ws + WS_HM, DFF / 2, ws + WS_MD, DFF / 2); S.blk_e = (const int*)(ws + WS_BLK_E); S.b_estride = (size_t)1024 * DFF; S.first = R * F.G; S.nhalf = Lc;
                  pg8::gemm_phase<pg8::EpiStoreQ, pg8::Sched, true, true, true, 2>(F.lds, F.tid, DFF / 2, DFF / 2, DFF / 2, S, E); }
            PHASE_END
            PHASE_BEGIN
                p_combine_final(F, A);
            PHASE_END
        }
        }
    { constexpr int l = 1;
        if (l == 1) {
            PHASE_BEGIN
                p_norm<24, true>(F, (const float*)(ws + WS_XB), A->in[1] + D, XN, A->in[2] + (size_t)D * NIN, NIN, 2560, 4624, A->in[3] + NIN, ZS, nullptr, nullptr);
            PHASE_END
        }
        PHASE_BEGIN
            pg8::Sched S; S.init(T / 256, 20, F.G, F.bx, XN, D, (bf16_t*)(ws + WS_WIN) + (size_t)l * 8192 * 1024, D);
            pg8::EpiInproj E{ZA, ZG, A->in[3] + l * NIN, ws};
            pg8::gemm_phase<pg8::EpiInproj, pg8::Sched, true, true>(F.lds, F.tid, D, D, D, S, E);
        PHASE_END
        PHASE_BEGIN
            p_mixer_prep(F, A, l);
            REFRAME();
            { const Half H = make_half(F); for (int u = F.vcu + (F.wave >> 2) * F.G; u < 1024; u += 2 * F.G) gla_local_h(H, F, A, u, l); }
            REFRAME();
            { const Half H = make_half(F); for (int u = F.vcu + (F.wave >> 2) * F.G; u < 1024; u += 2 * F.G) mlstm_local_h(H, F, A, u, l); }
        PHASE_END
        PHASE_BEGIN
            if (l == 0) p_prep_l0_late(F, A);
            REFRAME();
            p_mixer_scan(F);
            REFRAME();
            p_moba_select(F, l);
        PHASE_END
        PHASE_BEGIN
            { const Half H = make_half(F); for (int u = F.vcu + (F.wave >> 2) * F.G; u < 1024; u += 2 * F.G) gla_out_h(H, F, A, u, l); }
            REFRAME();
            { const Half H = make_half(F); for (int u = F.vcu + (F.wave >> 2) * F.G; u < 1024; u += 2 * F.G) mlstm_out_h(H, F, u); }
        PHASE_END
        PHASE_BEGIN
            p_moba_sparse(F, l);
        PHASE_END
        PHASE_BEGIN
            p_moba_combine(F);
            REFRAME();
            pg8::Sched S; S.init(T / 256, 12, F.G, F.bx, XN, D, (bf16_t*)(ws + WS_WIN) + (size_t)l * 8192 * 1024, D); S.pn0 = 20;
            pg8::EpiInproj E{ZA, ZG, A->in[3] + l * NIN, ws};
            pg8::gemm_phase<pg8::EpiInproj, pg8::Sched, true, true>(F.lds, F.tid, D, D, D, S, E);
        PHASE_END
        PHASE_BEGIN
            pg8::Sched S; S.init(T / 256, 4, F.G, F.bx, Y012, 512, (bf16_t*)(ws + WS_WUP) + (size_t)l * 3072 * 512, 512); S.a_split_tiles = 4; S.a_split_bytes = (size_t)T * 512 * 2; S.branch3 = 1;
            pg8::EpiUpGate E{U, ZG};
            pg8::gemm_phase<pg8::EpiUpGate, pg8::Sched, true, true>(F.lds, F.tid, 512, 512, 512, S, E);
        PHASE_END
        PHASE_BEGIN
            pg8::Sched S; S.init(T / 256, D / 256, F.G, F.bx, U, D, (bf16_t*)(ws + WS_WO3) + (size_t)l * 1024 * 1024, D);
            if (l == 0) { pg8::EpiResidT<false, true> E{A->in[0], ws + WS_XB}; pg8::gemm_phase<pg8::EpiResidT<false, true>, pg8::Sched, true, true>(F.lds, F.tid, D, D, D, S, E); }
            else { pg8::EpiResidT<true, true> E{ws + WS_XB, ws + WS_XB}; pg8::gemm_phase<pg8::EpiResidT<true, true>, pg8::Sched, true, true>(F.lds, F.tid, D, D, D, S, E); }
        PHASE_END
        if (l == 0) {
            PHASE_BEGIN
                p_prep_small_weights(F, A, 1);
                p_norm<0, true>(F, (const float*)(ws + WS_XB), A->in[13], XN, nullptr, 0, 0, 0, nullptr, nullptr, nullptr, nullptr);
            PHASE_END
            PHASE_BEGIN
                pg8::EpiSwiglu E{HD}; const int units = (T / 256) * 22, R = units / F.G, Lc = units - R * F.G; const bool hs = Lc > 0 && 2 * Lc <= F.G && R > 0;
                { pg8::Sched S; S.init(T / 256, 5632 / 256, F.G, F.bx, XN, D, ws + WS_WFGU, D); if (hs) S.lim = R * F.G;
                  pg8::gemm_phase<pg8::EpiSwiglu, pg8::Sched, true, true>(F.lds, F.tid, D, D, D, S, E); }
                if (hs) { pg8::Sched S; S.init(T / 256, 5632 / 256, F.G, F.bx, XN, D, ws + WS_WFGU, D); S.first = R * F.G; S.nhalf = Lc;
                  pg8::gemm_phase<pg8::EpiSwiglu, pg8::Sched, true, true, true>(F.lds, F.tid, D, D, D, S, E); }
            PHASE_END
            PHASE_BEGIN
                pg8::Sched S; S.init(T / 256, D / 256, F.G, F.bx, HD, DFF, ws + WS_WFD, DFF);
                pg8::EpiResidT<true, true> E{ws + WS_XB, ws + WS_XB};
                pg8::gemm_phase<pg8::EpiResidT<true, true>, pg8::Sched, true, true>(F.lds, F.tid, DFF, DFF, DFF, S, E);
            PHASE_END
        } else {
            PHASE_BEGIN
                p_prep_moe_weights(F, A); __syncthreads();
                p_norm<8, true, true>(F, (const float*)(ws + WS_XB), A->in[13] + D, (bf16_t*)(ws + WS_XN2), A->in[17], 8, 0, 0, A->in[18], nullptr, (int*)(ws + WS_TOPE), (float*)(ws + WS_TOPG));
            PHASE_END
            PHASE_BEGIN
                p_route_gather(F);
            PHASE_END
            PHASE_BEGIN
                const int nb = *(const int*)(ws + WS_NBLK);
                const float* wam = (const float*)(ws + WS_CTL) + CW_WAMAX;
                pg8::EpiSwigluQ E{(bf16_t*)(ws + WS_HM), (const float*)(ws + WS_RSG), 1.f / pow2_scale(wam[0]), 1.f / pow2_scale(wam[64])}; const int units = nb * 22, R = units / F.G, Lc = units - R * F.G; const bool hs = Lc > 0 && 2 * Lc <= F.G && R > 0;
                { pg8::Sched S; S.init(nb, 5632 / 256, F.G, F.bx, ws + WS_YM, D / 2, ws + WS_MGU, D / 2); S.blk_e = (const int*)(ws + WS_BLK_E); S.b_estride = (size_t)5632 * 1024; if (hs) S.lim = R * F.G;
                  pg8::gemm_phase<pg8::EpiSwigluQ, pg8::Sched, true, true, false, 1>(F.lds, F.tid, D / 2, D / 2, D / 2, S, E); }
                if (hs) { pg8::Sched S; S.init(nb, 5632 / 256, F.G, F.bx, ws + WS_YM, D / 2, ws + WS_MGU, D / 2); S.blk_e = (const int*)(ws + WS_BLK_E); S.b_estride = (size_t)5632 * 1024; S.first = R * F.G; S.nhalf = Lc;
                  pg8::gemm_phase<pg8::EpiSwigluQ, pg8::Sched, true, true, true, 1>(F.lds, F.tid, D / 2, D / 2, D / 2, S, E); }
            PHASE_END
            PHASE_BEGIN
                const int nb = *(const int*)(ws + WS_NBLK);
                const float* wam = (const float*)(ws + WS_CTL) + CW_WAMAX;
                pg8::EpiStoreQ E{(bf16_t*)(ws + WS_YM), 1.f / pow2_scale(wam[128])}; const int units = nb * 4, R = units / F.G, Lc = units - R * F.G; const bool hs = Lc > 0 && 2 * Lc <= F.G && R > 0;
                { pg8::Sched S; S.init(nb, D / 256, F.G, F.bx, ws + WS_HM, DFF / 2, ws + WS_MD, DFF / 2); S.blk_e = (const int*)(ws + WS_BLK_E); S.b_estride = (size_t)1024 * DFF; if (hs) S.lim = R * F.G;
                  pg8::gemm_phase<pg8::EpiStoreQ, pg8::Sched, true, true, false, 2>(F.lds, F.tid, DFF / 2, DFF / 2, DFF / 2, S, E); }
                if (hs) { pg8::Sched S; S.init(nb, D / 256, F.G, F.bx, ws + WS_HM, DFF / 2, ws + WS_MD, DFF / 2); S.blk_e = (const int*)(ws + WS_BLK_E); S.b_estride = (size_t)1024 * DFF; S.first = R * F.G; S.nhalf = Lc;
                  pg8::gemm_phase<pg8::EpiStoreQ, pg8::Sched, true, true, true, 2>(F.lds, F.tid, DFF / 2, DFF / 2, DFF / 2, S, E); }
            PHASE_END
            PHASE_BEGIN
                p_combine_final(F, A);
            PHASE_END
        }
        }
#undef PHASE_BEGIN
#undef PHASE_END
}

#ifndef MK_SPLIT
#define MK_SPLIT 0
#endif
extern "C" void kernel_launch(void* const* d_in, const int* in_sizes, int n_in, void* d_out, int out_size, void* d_ws, size_t ws_size, hipStream_t stream) {
    static int grid = 0;
    if (grid == 0) {
        if (n_in != 23 || out_size != T * D || ws_size < WS_END) { fprintf(stderr, "kernel_launch: unexpected shapes (n_in %d out %d ws %zu)\n", n_in, out_size, ws_size); grid = -1; return; }
        int dev = 0, cus = 0, per_cu = 0;
        if (hipGetDevice(&dev) != hipSuccess || hipDeviceGetAttribute(&cus, hipDeviceAttributeMultiprocessorCount, dev) != hipSuccess) { grid = -1; return; }
        if (hipFuncSetAttribute((const void*)fwd, hipFuncAttributeMaxDynamicSharedMemorySize, LDS_BYTES) != hipSuccess) { fprintf(stderr, "kernel_launch: hipFuncSetAttribute failed\n"); grid = -1; return; }
        if (hipOccupancyMaxActiveBlocksPerMultiprocessor(&per_cu, (const void*)fwd, NTHREADS, LDS_BYTES) != hipSuccess || per_cu < 1) fprintf(stderr, "kernel_launch: occupancy query reports %d\n", per_cu);
        (void)hipGetLastError();
        grid = cus;
    }
    if (grid < 0) return;
    (void)hipMemsetAsync((char*)d_ws + WS_CTL, 0, CTL_ZERO_BYTES, stream);
    Args a{};
    for (int i = 0; i < 23; ++i) a.in[i] = (const float*)d_in[i];
    a.out = (float*)d_out; a.ws = (unsigned char*)d_ws;
#if MK_SPLIT
    for (int p = 0; p < N_PHASES; ++p) { a.ph_lo = p; a.ph_hi = p + 1; hipLaunchKernelGGL(fwd, dim3(grid), dim3(NTHREADS), LDS_BYTES, stream, a); }
#else
    a.ph_lo = 0; a.ph_hi = N_PHASES;
    hipLaunchKernelGGL(fwd, dim3(grid), dim3(NTHREADS), LDS_BYTES, stream, a);
#endif
}
```
